# Optimizing an MI355X kernel written in HIP

```python
import math
import jax
import jax.numpy as jnp
from jax import lax
import numpy as np

D_MODEL = 1024
BATCH = 16
SEQ = 4096
DEPTH = 2
DEC_BATCH = 16
DEC_SEQ = 32
PAST_LEN = 1024

CHUNK = 64
NORM_EPS = 1e-6
RWKV_GN_EPS = 64e-5
RES_HALF = 0.5
N_MOD = 9
S5_WIDTH = D_MODEL // 2
S5_GROUP = 16
S5_GROUPS = S5_WIDTH // S5_GROUP
S5_STATE = 64
RWKV_WIDTH = D_MODEL - S5_WIDTH
RWKV_HEAD = 64
RWKV_HEADS = RWKV_WIDTH // RWKV_HEAD
RWKV_W_LORA = 64
RWKV_A_LORA = 64
RWKV_G_LORA = 128
RWKV_COLS = 3 * RWKV_WIDTH + RWKV_W_LORA + RWKV_A_LORA + RWKV_G_LORA
AB_IN_COLS = S5_WIDTH + RWKV_COLS
HGRN_WIDTH = D_MODEL
HGRN_HEAD = 128
HGRN_HEADS = HGRN_WIDTH // HGRN_HEAD
C_IN_COLS = 4 * HGRN_WIDTH
D_FF = 2816
N_EVEN = (DEPTH + 1) // 2
N_ODD = DEPTH // 2

kernel_name = 'hybrid_streaming_s5_rwkv7_hgrn2_step'


def rmsnorm(x, g):
    xf = x.astype(jnp.float32)
    y = xf * lax.rsqrt(jnp.mean(xf * xf, axis=-1, keepdims=True) + NORM_EPS)
    return (y * g.astype(jnp.float32)).astype(x.dtype)


def modulate(h, shift, scale):
    return h * (1 + scale[:, None, :]) + shift[:, None, :]


def swiglu(h, w1, w3, w2):
    return (jax.nn.silu(h @ w1) * (h @ w3)) @ w2


def _complex_affine_combine(e1, e2):
    a1r, a1i, b1r, b1i = e1
    a2r, a2i, b2r, b2i = e2
    return (a1r * a2r - a1i * a2i, a1r * a2i + a1i * a2r,
            a2r * b1r - a2i * b1i + b2r, a2r * b1i + a2i * b1r + b2i)


def s5_mixer(u, h0_re, h0_im, lam_re, lam_im, log_dt, b_re, b_im, c_re, c_im, d_skip, w_glu):
    f32 = jnp.float32
    bsz, L, _ = u.shape
    uf = u.astype(f32).reshape(bsz, L, S5_GROUPS, S5_GROUP)
    dt = jnp.exp(log_dt.astype(f32))[:, None]
    lr = lam_re.astype(f32)
    li = lam_im.astype(f32)
    mag = jnp.exp(lr * dt)
    ab_re = mag * jnp.cos(li * dt)
    ab_im = mag * jnp.sin(li * dt)
    den = lr * lr + li * li
    z_re = ((ab_re - 1.0) * lr + ab_im * li) / den
    z_im = (ab_im * lr - (ab_re - 1.0) * li) / den
    br = b_re.astype(f32)
    bi = b_im.astype(f32)
    bb_re = z_re[..., None] * br - z_im[..., None] * bi
    bb_im = z_re[..., None] * bi + z_im[..., None] * br
    bu_re = jnp.einsum('blgh,gph->lbgp', uf, bb_re)
    bu_im = jnp.einsum('blgh,gph->lbgp', uf, bb_im)
    h0r = h0_re.astype(f32)
    h0i = h0_im.astype(f32)
    bu_re = bu_re.at[0].add(ab_re * h0r - ab_im * h0i)
    bu_im = bu_im.at[0].add(ab_re * h0i + ab_im * h0r)
    a_re = jnp.broadcast_to(ab_re, (L, 1) + ab_re.shape)
    a_im = jnp.broadcast_to(ab_im, (L, 1) + ab_im.shape)
    _, _, xr, xi = lax.associative_scan(_complex_affine_combine, (a_re, a_im, bu_re, bu_im), axis=0)
    y = (jnp.einsum('lbgp,ghp->blgh', xr, c_re.astype(f32))
         - jnp.einsum('lbgp,ghp->blgh', xi, c_im.astype(f32))
         + uf * d_skip.astype(f32))
    y = jax.nn.gelu(y.reshape(bsz, L, S5_WIDTH))
    y = y * jax.nn.sigmoid(y @ w_glu.astype(f32))
    return y.astype(u.dtype), xr[-1], xi[-1]


def _rwkv_step(S, inp):
    r_t, k_t, v_t, w_t, a_t, b_t = inp
    sa = jnp.einsum('bhvk,bhk->bhv', S, a_t)
    S = S * w_t[:, :, None, :] + sa[..., None] * b_t[:, :, None, :] + v_t[..., None] * k_t[:, :, None, :]
    return S, jnp.einsum('bhvk,bhk->bhv', S, r_t)


def rwkv7_mixer(p, shift_prev, s0, mu, w0, w_w2, a0, w_a2, w_g2, k_k, k_a, r_k, lnx_g, lnx_b):
    f32 = jnp.float32
    bsz, L, _ = p.shape
    W = RWKV_WIDTH
    p_prev = jnp.concatenate([shift_prev[:, None, :].astype(p.dtype), p[:, :-1]], axis=1)
    ps = p + (p_prev - p) * mu
    r, k, v, w_low, a_low, g_low = jnp.split(
        ps, [W, 2 * W, 3 * W, 3 * W + RWKV_W_LORA, 3 * W + RWKV_W_LORA + RWKV_A_LORA], axis=-1)
    logw = -jax.nn.softplus(-(w0 + jnp.tanh(w_low) @ w_w2).astype(f32)) - 0.5
    decay = jnp.exp(-jnp.exp(logw))
    a = jax.nn.sigmoid((a0 + a_low @ w_a2).astype(f32))
    g = jax.nn.sigmoid(g_low) @ w_g2
    hd = (bsz, L, RWKV_HEADS, RWKV_HEAD)
    kk = (k * k_k).astype(f32).reshape(hd)
    kk = kk / jnp.maximum(jnp.linalg.norm(kk, axis=-1, keepdims=True), 1e-12)
    k = (k.astype(f32) * (1 + (a - 1) * k_a.astype(f32))).reshape(hd)
    r = r.astype(f32).reshape(hd)
    v = v.astype(f32).reshape(hd)
    a_h = a.reshape(hd)
    decay = decay.reshape(hd)
    tm = lambda t: jnp.moveaxis(t, 1, 0)
    S, ys = lax.scan(_rwkv_step, s0.astype(f32),
                     (tm(r), tm(k), tm(v), tm(decay), tm(-kk), tm(kk * a_h)))
    y = jnp.moveaxis(ys, 0, 1)
    mean = jnp.mean(y, axis=-1, keepdims=True)
    var = jnp.mean(jnp.square(y - mean), axis=-1, keepdims=True)
    y = ((y - mean) * lax.rsqrt(var + RWKV_GN_EPS)).reshape(bsz, L, W) * lnx_g + lnx_b
    bonus = jnp.sum(r * k * r_k.astype(f32), axis=-1, keepdims=True) * v
    y = (y + bonus.reshape(bsz, L, W)) * g
    return y.astype(p.dtype), p[:, -1], S


def gated_linear_chunked(q, k, v, log_f, s0):
    bsz, L, H, K = q.shape
    n = -(-L // CHUNK)
    pad = n * CHUNK - L
    padw = ((0, 0), (0, pad), (0, 0), (0, 0))
    q, k, v, log_f = [jnp.pad(t, padw) for t in (q, k, v, log_f)]
    blocks = lambda t: t.reshape(bsz, n, CHUNK, H, t.shape[-1]).transpose(1, 0, 3, 2, 4)
    tri = jnp.tril(jnp.ones((CHUNK, CHUNK), dtype=bool))[:, :, None]

    def step(S, inp):
        qc, kc, vc, gc = inp
        b = jnp.cumsum(gc, axis=2)
        diff = jnp.where(tri, b[:, :, :, None, :] - b[:, :, None, :, :], -jnp.inf)
        att = jnp.einsum('bhtk,bhtsk,bhsk->bhts', qc, jnp.exp(diff), kc)
        o = jnp.einsum('bhts,bhsv->bhtv', att, vc) + jnp.einsum('bhtk,bhkv->bhtv', qc * jnp.exp(b), S)
        b_last = b[:, :, -1:, :]
        S = S * jnp.exp(b_last[:, :, 0, :, None]) + jnp.einsum('bhsk,bhsv->bhkv', kc * jnp.exp(b_last - b), vc)
        return S, o

    S, o = lax.scan(step, s0, (blocks(q), blocks(k), blocks(v), blocks(log_f)))
    o = o.transpose(1, 0, 3, 2, 4).reshape(bsz, n * CHUNK, H, v.shape[-1])[:, :L]
    return o, S


def hgrn2_mixer(p, s0, lb, gnorm):
    f32 = jnp.float32
    bsz, L, _ = p.shape
    q, f, v, g = jnp.split(p, 4, axis=-1)
    q = jax.nn.silu(q).astype(f32)
    f = f.astype(f32)
    log_f = jnp.logaddexp(jnp.log(lb), jnp.log1p(-lb) + jax.nn.log_sigmoid(f))
    k = (1 - lb) * jax.nn.sigmoid(-f)
    hd = (bsz, L, HGRN_HEADS, HGRN_HEAD)
    o, S = gated_linear_chunked(q.reshape(hd), k.reshape(hd), v.astype(f32).reshape(hd),
                                log_f.reshape(hd), s0.astype(f32))
    o = rmsnorm(o, gnorm).reshape(bsz, L, HGRN_WIDTH) * jax.nn.silu(g.astype(f32))
    return o.astype(p.dtype), S


def trunk(x, c, s5_re, s5_im, rwkv_s, rwkv_shift, hgrn_s, P):
    lb_all = jax.nn.softmax(P['hgrn_lower_bounds'].astype(jnp.float32), axis=0)
    lb_all = jnp.cumsum(lb_all, axis=0) - lb_all[0]
    cs = jax.nn.silu(c)
    n_re, n_im, n_rw, n_sh, n_hg = [], [], [], [], []
    for l in range(DEPTH):
        mods = cs @ P['w_ada'][l] + P['b_ada'][l]
        sh1, sc1, g1, sh2, sc2, g2, sh3, sc3, g3 = jnp.split(mods, N_MOD, axis=-1)
        h = modulate(rmsnorm(x, P['norm_ffn1'][l]), sh1, sc1)
        x = x + RES_HALF * (1 + g1[:, None]) * swiglu(h, P['ffn1_w1'][l], P['ffn1_w3'][l], P['ffn1_w2'][l])
        h = modulate(rmsnorm(x, P['norm_mix'][l]), sh2, sc2)
        i = l // 2
        if l % 2 == 0:
            p = h @ P['ab_w_in'][i]
            ya, hr, hi = s5_mixer(p[..., :S5_WIDTH], s5_re[i], s5_im[i], P['s5_lam_re'][i], P['s5_lam_im'][i],
                                  P['s5_log_dt'][i], P['s5_b_re'][i], P['s5_b_im'][i], P['s5_c_re'][i],
                                  P['s5_c_im'][i], P['s5_d'][i], P['s5_w_glu'][i])
            yb, sh_new, rw_new = rwkv7_mixer(p[..., S5_WIDTH:], rwkv_shift[i], rwkv_s[i], P['rwkv_mu'][i],
                                             P['rwkv_w0'][i], P['rwkv_w_w2'][i], P['rwkv_a0'][i],
                                             P['rwkv_w_a2'][i], P['rwkv_w_g2'][i], P['rwkv_k_k'][i],
                                             P['rwkv_k_a'][i], P['rwkv_r_k'][i], P['rwkv_lnx_g'][i],
                                             P['rwkv_lnx_b'][i])
            y = jnp.concatenate([ya, yb], axis=-1) @ P['ab_w_out'][i]
            n_re.append(hr)
            n_im.append(hi)
            n_rw.append(rw_new)
            n_sh.append(sh_new)
        else:
            p = h @ P['c_w_in'][i]
            yc, hg_new = hgrn2_mixer(p, hgrn_s[i], lb_all[l], P['hgrn_gnorm'][i])
            y = yc @ P['c_w_out'][i]
            n_hg.append(hg_new)
        x = x + (1 + g2[:, None]) * y
        h = modulate(rmsnorm(x, P['norm_ffn2'][l]), sh3, sc3)
        x = x + RES_HALF * (1 + g3[:, None]) * swiglu(h, P['ffn2_w1'][l], P['ffn2_w3'][l], P['ffn2_w2'][l])
    y = rmsnorm(x, P['final_norm'])
    return (y, jnp.stack(n_re).astype(s5_re.dtype), jnp.stack(n_im).astype(s5_im.dtype),
            jnp.stack(n_rw).astype(rwkv_s.dtype), jnp.stack(n_sh).astype(rwkv_shift.dtype),
            jnp.stack(n_hg).astype(hgrn_s.dtype))


def setup_inputs(seed: int = 0) -> dict:
    key = jax.random.key(seed)
    ks = iter(jax.random.split(key, 64))
    f32 = jnp.float32

    def nrm(shape, scale):
        return jax.random.normal(next(ks), shape, f32) * scale

    def unif(shape, lo, hi):
        return jax.random.uniform(next(ks), shape, f32, lo, hi)

    D = D_MODEL
    G, Pst, H = S5_GROUPS, S5_STATE, S5_GROUP
    W = RWKV_WIDTH
    w0_base = -6.0 + 5.0 * (jnp.arange(W, dtype=f32) / (W - 1)) ** 0.85
    lam_im_base = jnp.pi * jnp.arange(Pst, dtype=f32)
    return {
        'x_prompt': nrm((BATCH, SEQ, D), 1.0),
        'x_sample': nrm((DEC_BATCH, DEC_SEQ, D), 1.0),
        'state_s5_re': nrm((N_EVEN, DEC_BATCH, G, Pst), 0.1),
        'state_s5_im': nrm((N_EVEN, DEC_BATCH, G, Pst), 0.1),
        'state_rwkv': nrm((N_EVEN, DEC_BATCH, RWKV_HEADS, RWKV_HEAD, RWKV_HEAD), 0.1),
        'state_rwkv_shift': nrm((N_EVEN, DEC_BATCH, RWKV_COLS), 1.0),
        'state_hgrn': nrm((N_ODD, DEC_BATCH, HGRN_HEADS, HGRN_HEAD, HGRN_HEAD), 0.5),
        'c_prompt': nrm((BATCH, D), 1.0),
        'c_sample': nrm((DEC_BATCH, D), 1.0),
        'w_ada': nrm((DEPTH, D, N_MOD * D), 0.5 * D ** -0.5),
        'b_ada': nrm((DEPTH, N_MOD * D), 0.01),
        'norm_ffn1': 1.0 + nrm((DEPTH, D), 0.02),
        'norm_mix': 1.0 + nrm((DEPTH, D), 0.02),
        'norm_ffn2': 1.0 + nrm((DEPTH, D), 0.02),
        'ffn1_w1': nrm((DEPTH, D, D_FF), D ** -0.5),
        'ffn1_w3': nrm((DEPTH, D, D_FF), D ** -0.5),
        'ffn1_w2': nrm((DEPTH, D_FF, D), D_FF ** -0.5),
        'ffn2_w1': nrm((DEPTH, D, D_FF), D ** -0.5),
        'ffn2_w3': nrm((DEPTH, D, D_FF), D ** -0.5),
        'ffn2_w2': nrm((DEPTH, D_FF, D), D_FF ** -0.5),
        'ab_w_in': nrm((N_EVEN, D, AB_IN_COLS), D ** -0.5),
        'ab_w_out': nrm((N_EVEN, S5_WIDTH + RWKV_WIDTH, D), (S5_WIDTH + RWKV_WIDTH) ** -0.5),
        's5_lam_re': -0.5 + nrm((N_EVEN, G, Pst), 0.01),
        's5_lam_im': lam_im_base + nrm((N_EVEN, G, Pst), 0.01),
        's5_log_dt': unif((N_EVEN, G), math.log(0.001), math.log(0.1)),
        's5_b_re': nrm((N_EVEN, G, Pst, H), H ** -0.5),
        's5_b_im': nrm((N_EVEN, G, Pst, H), H ** -0.5),
        's5_c_re': nrm((N_EVEN, G, H, Pst), Pst ** -0.5),
        's5_c_im': nrm((N_EVEN, G, H, Pst), Pst ** -0.5),
        's5_d': nrm((N_EVEN, G, H), 1.0),
        's5_w_glu': nrm((N_EVEN, S5_WIDTH, S5_WIDTH), S5_WIDTH ** -0.5),
        'rwkv_mu': unif((N_EVEN, RWKV_COLS), 0.0, 1.0),
        'rwkv_w0': w0_base + nrm((N_EVEN, W), 0.05),
        'rwkv_w_w2': nrm((N_EVEN, RWKV_W_LORA, W), 0.1),
        'rwkv_a0': nrm((N_EVEN, W), 0.1),
        'rwkv_w_a2': nrm((N_EVEN, RWKV_A_LORA, W), 0.1),
        'rwkv_w_g2': nrm((N_EVEN, RWKV_G_LORA, W), RWKV_G_LORA ** -0.5),
        'rwkv_k_k': 0.85 + nrm((N_EVEN, W), 0.02),
        'rwkv_k_a': 1.0 + nrm((N_EVEN, W), 0.02),
        'rwkv_r_k': nrm((N_EVEN, RWKV_HEADS, RWKV_HEAD), 0.1),
        'rwkv_lnx_g': 1.0 + nrm((N_EVEN, W), 0.02),
        'rwkv_lnx_b': nrm((N_EVEN, W), 0.01),
        'c_w_in': nrm((N_ODD, D, C_IN_COLS), D ** -0.5),
        'c_w_out': nrm((N_ODD, HGRN_WIDTH, D), HGRN_WIDTH ** -0.5),
        'hgrn_lower_bounds': nrm((DEPTH, HGRN_WIDTH), 0.1),
        'hgrn_gnorm': 1.0 + nrm((N_ODD, HGRN_HEAD), 0.02),
        'final_norm': 1.0 + nrm((D,), 0.02),
    }


def reference(x_prompt, x_sample, state_s5_re, state_s5_im, state_rwkv, state_rwkv_shift, state_hgrn,
              c_prompt, c_sample, w_ada, b_ada, norm_ffn1, norm_mix, norm_ffn2,
              ffn1_w1, ffn1_w3, ffn1_w2, ffn2_w1, ffn2_w3, ffn2_w2, ab_w_in, ab_w_out,
              s5_lam_re, s5_lam_im, s5_log_dt, s5_b_re, s5_b_im, s5_c_re, s5_c_im, s5_d, s5_w_glu,
              rwkv_mu, rwkv_w0, rwkv_w_w2, rwkv_a0, rwkv_w_a2, rwkv_w_g2, rwkv_k_k, rwkv_k_a, rwkv_r_k,
              rwkv_lnx_g, rwkv_lnx_b, c_w_in, c_w_out, hgrn_lower_bounds, hgrn_gnorm, final_norm):
    P = dict(w_ada=w_ada, b_ada=b_ada, norm_ffn1=norm_ffn1, norm_mix=norm_mix, norm_ffn2=norm_ffn2,
             ffn1_w1=ffn1_w1, ffn1_w3=ffn1_w3, ffn1_w2=ffn1_w2, ffn2_w1=ffn2_w1, ffn2_w3=ffn2_w3,
             ffn2_w2=ffn2_w2, ab_w_in=ab_w_in, ab_w_out=ab_w_out, s5_lam_re=s5_lam_re, s5_lam_im=s5_lam_im,
             s5_log_dt=s5_log_dt, s5_b_re=s5_b_re, s5_b_im=s5_b_im, s5_c_re=s5_c_re, s5_c_im=s5_c_im,
             s5_d=s5_d, s5_w_glu=s5_w_glu, rwkv_mu=rwkv_mu, rwkv_w0=rwkv_w0, rwkv_w_w2=rwkv_w_w2,
             rwkv_a0=rwkv_a0, rwkv_w_a2=rwkv_w_a2, rwkv_w_g2=rwkv_w_g2, rwkv_k_k=rwkv_k_k,
             rwkv_k_a=rwkv_k_a, rwkv_r_k=rwkv_r_k, rwkv_lnx_g=rwkv_lnx_g, rwkv_lnx_b=rwkv_lnx_b,
             c_w_in=c_w_in, c_w_out=c_w_out, hgrn_lower_bounds=hgrn_lower_bounds, hgrn_gnorm=hgrn_gnorm,
             final_norm=final_norm)
    dt = x_prompt.dtype
    bp = x_prompt.shape[0]
    z_re = jnp.zeros((N_EVEN, bp, S5_GROUPS, S5_STATE), dt)
    z_im = jnp.zeros((N_EVEN, bp, S5_GROUPS, S5_STATE), dt)
    z_rw = jnp.zeros((N_EVEN, bp, RWKV_HEADS, RWKV_HEAD, RWKV_HEAD), dt)
    z_sh = jnp.zeros((N_EVEN, bp, RWKV_COLS), dt)
    z_hg = jnp.zeros((N_ODD, bp, HGRN_HEADS, HGRN_HEAD, HGRN_HEAD), dt)
    y_prompt, s5_re_p, s5_im_p, rwkv_p, rwkv_shift_p, hgrn_p = trunk(
        x_prompt, c_prompt, z_re, z_im, z_rw, z_sh, z_hg, P)
    y_sample, s5_re_s, s5_im_s, rwkv_s, rwkv_shift_s, hgrn_s = trunk(
        x_sample, c_sample, state_s5_re, state_s5_im, state_rwkv, state_rwkv_shift, state_hgrn, P)
    return (y_prompt, y_sample, s5_re_p, s5_im_p, rwkv_p, rwkv_shift_p, hgrn_p,
            s5_re_s, s5_im_s, rwkv_s, rwkv_shift_s, hgrn_s)
```

```cpp
#include <hip/hip_runtime.h>
#include <hip/hip_cooperative_groups.h>
#include <cstdio>
#include <cstdint>
namespace cg = cooperative_groups;

#define LAS __attribute__((address_space(3)))
#define DEV __device__ __forceinline__
typedef unsigned short bf16_t;
typedef short bf16x8 __attribute__((ext_vector_type(8)));
typedef float f32x4 __attribute__((ext_vector_type(4)));
typedef unsigned u32x4 __attribute__((ext_vector_type(4)));
typedef unsigned u32x2 __attribute__((ext_vector_type(2)));

constexpr int MT = 66048, MP = 65536, DM = 1024, FF = 2816, NMODS = 18432;
constexpr int LDP_E = 2304, LDP_O = 4096;
constexpr size_t O_Y = 0, O_S5RE_P = (size_t)MT * DM, O_S5IM_P = O_S5RE_P + 32768, O_RWKV_P = O_S5IM_P + 32768, O_SHIFT_P = O_RWKV_P + 524288,
                 O_HGRN_P = O_SHIFT_P + 28672, O_S5RE_S = O_HGRN_P + 2097152, O_S5IM_S = O_S5RE_S + 32768, O_RWKV_S = O_S5IM_S + 32768,
                 O_SHIFT_S = O_RWKV_S + 524288, O_HGRN_S = O_SHIFT_S + 28672, O_END = O_HGRN_S + 2097152;
constexpr size_t SZ_H = (size_t)MT * DM * 2;
constexpr size_t W_UP = 0, SZ_UP = (size_t)5632 * 1024 * 2, W_DN = W_UP + 4 * SZ_UP, SZ_DN = (size_t)1024 * 2816 * 2, W_ABIN = W_DN + 4 * SZ_DN,
                 W_ABOUT = W_ABIN + (size_t)2304 * 1024 * 2, W_GLU = W_ABOUT + (size_t)1024 * 1024 * 2, W_LORA = W_GLU + (size_t)512 * 512 * 2,
                 W_CIN = W_LORA + (size_t)1536 * 256 * 2, W_COUT = W_CIN + (size_t)4096 * 1024 * 2, SZ_W = W_COUT + (size_t)1024 * 1024 * 2;
constexpr size_t OFF_H = 0, OFF_W = OFF_H + SZ_H, OFF_MODS = OFF_W + SZ_W, OFF_ACS = OFF_MODS + (size_t)32 * NMODS * 4, OFF_TAB = OFF_ACS + (size_t)256 * 1024 * 2,
                 OFF_S5E = OFF_TAB + 294912, OFF_S5ES = OFF_S5E + (size_t)512 * 64 * 128 * 4, OFF_B = OFF_S5ES + (size_t)512 * 128 * 4;
constexpr size_t B_P = 0, B_LORA = B_P + (size_t)MT * 2304 * 2, B_DECAY = B_LORA + (size_t)MT * 256 * 2, B_ABUF = B_DECAY + (size_t)MT * 512 * 4,
                 B_GBUF = B_ABUF + (size_t)MT * 512 * 2, B_YA = B_GBUF + (size_t)MT * 512 * 2, B_YRAW = B_YA + (size_t)MT * 512 * 2, B_END = B_YRAW + (size_t)MT * 512 * 4;
constexpr size_t B_PART = 400000000;
constexpr size_t B_ADA = B_YRAW;
constexpr size_t B_ORAW = (size_t)MT * 4096 * 2;
constexpr size_t OFF_BAR = OFF_B + B_END;
constexpr size_t WS_NEED = OFF_BAR + 16384;
constexpr int T_AB = 0, T_BBRE = 4096, T_BBIM = T_BBRE + 32768, T_LB = T_BBIM + 32768;

#ifndef DBL_MASK
#define DBL_MASK 0
#endif
#ifndef PH_MASK
#define PH_MASK 0x3FFFF
#endif
struct Params { const float* in[47]; float* out; unsigned char* ws; };
typedef const __attribute__((address_space(4))) Params& CP;

DEV unsigned cvt_pk_bf16(float lo, float hi) { unsigned r; asm volatile("v_cvt_pk_bf16_f32 %0, %1, %2" : "=v"(r) : "v"(lo), "v"(hi)); return r; }
DEV float bf2f(bf16_t b) { return __uint_as_float(((unsigned)b) << 16); }
DEV float bflo(unsigned u) { return __uint_as_float(u << 16); }
DEV float bfhi(unsigned u) { return __uint_as_float(u & 0xffff0000u); }
DEV bf16_t f2bf(float f) { return (bf16_t)(cvt_pk_bf16(f, 0.f) & 0xffffu); }
DEV float wave_sum(float v) {
#pragma unroll
    for (int o = 1; o < 64; o <<= 1) v += __shfl_xor(v, o);
    return v;
}
template <int CTRL> DEV float dppf(float v) { return __int_as_float(__builtin_amdgcn_update_dpp(0, __float_as_int(v), CTRL, 0xF, 0xF, true)); }
DEV float red8(float v) { v += dppf<0xB1>(v); v += dppf<0x4E>(v); v += dppf<0x141>(v); return v; }
DEV float red16(float v) { v = red8(v); v += dppf<0x140>(v); return v; }
DEV float sigmoidf_(float x) { return __builtin_amdgcn_rcpf(1.f + __expf(-x)); }
DEV float siluf_(float x) { return x * __builtin_amdgcn_rcpf(1.f + __expf(-x)); }
DEV int tid_() { int t = threadIdx.x; asm volatile("" : "+v"(t)); return t; }
DEV int gdim_() { int g = gridDim.x; asm volatile("" : "+s"(g)); return g; }
DEV int bid_() { int b = blockIdx.x; asm volatile("" : "+s"(b)); return b; }
DEV const __attribute__((address_space(4))) Params* params_() { const __attribute__((address_space(4))) Params* q = (const __attribute__((address_space(4))) Params*)__builtin_amdgcn_kernarg_segment_ptr(); asm volatile("" : "+s"(q)); return q; }
#define PP (*params_())
DEV int brow(int r) { return r < MP ? (r >> 12) : 16 + ((r - MP) >> 5); }


#define XB_TMO      128
#define XB_XCNT(j)  (256  + 64 * (j))
#define XB_XSUB(j)  (1280 + 64 * (j))
#define XB_XGEN(j)  (2304 + 64 * (j))
#define XB_TOP      3328
#define XB_TOPGEN   3392
#define XCD_BAR_WORDS 3456
#define XB_SPIN_CAP (1u << 18)
DEV unsigned xb_ld(unsigned* p)              { return __hip_atomic_load(p, __ATOMIC_RELAXED, __HIP_MEMORY_SCOPE_AGENT); }
DEV unsigned xb_add(unsigned* p, unsigned v) { return __hip_atomic_fetch_add(p, v, __ATOMIC_RELAXED, __HIP_MEMORY_SCOPE_AGENT); }
DEV unsigned xb_xcc_id() { return (unsigned)__builtin_amdgcn_s_getreg((3 << 11) | 20) & 0xFu; }
#define XB_SPIN(cond, bar) do { unsigned _sp = 0; while (cond) { __builtin_amdgcn_s_sleep(1); \
    if ((++_sp & 255u) == 0u) { if (xb_ld(&(bar)[XB_TMO])) break; if (_sp > XB_SPIN_CAP) { atomicAdd(&(bar)[XB_TMO], 1u); break; } } } } while (0)
struct XcdBarrier { unsigned* bar; unsigned x; volatile LAS unsigned* st; };
DEV XcdBarrier xcd_barrier_post(unsigned* bar, volatile LAS unsigned* st) {
    XcdBarrier b; b.bar = bar; b.x = xb_xcc_id(); b.st = st;
    if (threadIdx.x == 0) (void)xb_add(&bar[XB_XCNT(b.x)], 1u);
    return b;
}
DEV void xcd_barrier_complete(unsigned* bar, unsigned x, unsigned& nloc, unsigned& nx) {
    const unsigned G = gridDim.x * gridDim.y * gridDim.z;
    unsigned sum, cnt, mine, sp = 0u;
    for (;;) {
        sum = 0u; cnt = 0u; mine = 0u;
#pragma unroll
        for (unsigned j = 0; j < 16; ++j) { const unsigned c = xb_ld(&bar[XB_XCNT(j)]); sum += c; cnt += (c > 0u) ? 1u : 0u; mine = (j == x) ? c : mine; }
        if (sum == G) break;
        __builtin_amdgcn_s_sleep(1);
        if ((++sp & 255u) == 0u) { if (xb_ld(&bar[XB_TMO])) break; if (sp > XB_SPIN_CAP) { atomicAdd(&bar[XB_TMO], 1u); break; } }
    }
    nloc = mine > 0u ? mine : 1u; nx = cnt > 0u ? cnt : 1u;
}
DEV void xcd_barrier(const XcdBarrier& b) {
    asm volatile("s_waitcnt vmcnt(0)" ::: "memory");
    __syncthreads();
    if (threadIdx.x == 0) {
        unsigned* bar = b.bar;
        __builtin_amdgcn_s_waitcnt(0);
        unsigned nloc = b.st[0], nx = b.st[1];
        if (nloc == 0u) { xcd_barrier_complete(bar, b.x, nloc, nx); b.st[0] = nloc; b.st[1] = nx; }
        const unsigned old = xb_add(&bar[XB_XSUB(b.x)], 1u);
        const unsigned gen = old / nloc;
        if (old + 1u == (gen + 1u) * nloc) {
            __builtin_amdgcn_fence(__ATOMIC_RELEASE, "agent");
            asm volatile("s_waitcnt vmcnt(0)" ::: "memory");
            const unsigned og = xb_add(&bar[XB_TOP], 1u);
            const unsigned tg = og / nx;
            if (og + 1u == (tg + 1u) * nx) xb_add(&bar[XB_TOPGEN], 1u);
            else XB_SPIN(xb_ld(&bar[XB_TOPGEN]) == tg, bar);
            __builtin_amdgcn_fence(__ATOMIC_ACQUIRE, "agent");
            xb_add(&bar[XB_XGEN(b.x)], 1u);
            asm volatile("s_waitcnt vmcnt(0)" ::: "memory");
        } else {
            XB_SPIN(xb_ld(&bar[XB_XGEN(b.x)]) == gen, bar);
            __builtin_amdgcn_fence(__ATOMIC_ACQUIRE, "agent");
            asm volatile("s_waitcnt vmcnt(0)" ::: "memory");
        }
    }
    __syncthreads();
}

namespace pg8 {
constexpr int BM = 256, BK = 64, HALF = 128, HTB = HALF * BK * 2, STAGE_BYTES = 8 * HTB, NXCD = 8, WGM = 8;
DEV int lds_byte(int r, int c) { const int st = (r >> 4) * 2 + (c >> 5), rr = r & 15, cc = c & 31, ob = rr * 64 + cc * 2; return st * 1024 + (ob ^ (((ob >> 9) & 1) << 5)); }
DEV void stage_rc(int b, int& R, int& C) { const int st = b / 1024, sb = b % 1024, swz = sb ^ (((sb >> 9) & 1) << 5); R = (st >> 1) * 16 + swz / 64; C = (st & 1) * 32 + (swz % 64) / 2; }
struct Unit { int pm, pn, kc; };
struct Gemm { const bf16_t* A; const bf16_t* Bt; int M, N, K, ld; };
struct StaticOrder {
    int nM, nN, nwg, G, c;
    DEV void init(int M, int N, int G_, int c_) { nM = M / BM; nN = N / BM; nwg = nM * nN; G = G_; c = c_; }
    DEV bool next(int i, Unit& u) const {
        const long L = (long)i * G + c; if (L >= nwg) return false;
        int wgid = (int)L; { const int q = nwg / NXCD, r = nwg % NXCD, xcd = wgid % NXCD, off = wgid / NXCD; wgid = (xcd < r ? xcd * (q + 1) : r * (q + 1) + (xcd - r) * q) + off; }
        const int nig = WGM * nN, gid = wgid / nig, fm = gid * WGM, gsz = (nM - fm) < WGM ? (nM - fm) : WGM;
        u.pm = fm + ((wgid % nig) % gsz); u.pn = (wgid % nig) / gsz; u.kc = 0; return true;
    }
};
struct SplitOrder {
    int nN, nkc, G, c;
    DEV void init(int N, int nkc_, int G_, int c_) { nN = N / BM; nkc = nkc_; G = G_; c = c_; }
    DEV bool next(int i, Unit& u) const {
        const int L = i * G + c; if (L >= 2 * nN * nkc) return false;
        const int rem = L % (2 * nN); u.kc = L / (2 * nN); u.pm = 256 + rem / nN; u.pn = rem % nN; return true;
    }
};
template <class Epi, class Sched>
DEV void gemm_phase(LAS unsigned char* lds, const Gemm g, const Sched& S, const Epi& E) {
    const int tid = tid_(), wid = __builtin_amdgcn_readfirstlane(tid >> 6), lane = tid & 63, wr = wid >> 2, wc = wid & 3, fr = lane & 15, fq = lane >> 4;
    int K = g.K; asm volatile("" : "+s"(K));
    const int nt = K / BK;
    int LD = g.ld; asm volatile("" : "+s"(LD));
    unsigned voffA[2];
#pragma unroll
    for (int i = 0; i < 2; ++i) { int R, C; stage_rc(tid * 16 + i * 8192, R, C); voffA[i] = (unsigned)(R * LD + C) * 2u; }
    const size_t kstep = (size_t)(BK * 2);
    const size_t hstep = (size_t)HALF * LD * 2;
    const size_t cstep = (size_t)K * 2;
    const size_t tstep = 2 * hstep;
    const unsigned ldsw = (unsigned)wid * 1024u;
    const int aoff = lds_byte(wr * 64 + fr, fq * 8), boff = lds_byte(wc * 32 + fr, fq * 8);
#define PG8_SA(b, h) (((b) * 2 + (h)) * HTB)
#define PG8_SB(b, h) ((4 + (b) * 2 + (h)) * HTB)
#define PG8_STAGE(bufoff, gbase, voff) do { _Pragma("unroll") for (int _i = 0; _i < 2; ++_i) \
        __builtin_amdgcn_global_load_lds((const unsigned*)((const char*)(gbase) + (voff)[_i]), (LAS unsigned*)(lds + (bufoff) + ldsw + _i * 8192), 16, 0, 0); } while (0)
#define PG8_LDA(dst, b, h) do { _Pragma("unroll") for (int m = 0; m < 4; ++m) _Pragma("unroll") for (int k = 0; k < 2; ++k) dst[m][k] = *(const LAS bf16x8*)(lds + PG8_SA(b, h) + aoff + m * 2048 + k * 1024); } while (0)
#define PG8_LDB(dst, b, h) do { _Pragma("unroll") for (int n = 0; n < 2; ++n) _Pragma("unroll") for (int k = 0; k < 2; ++k) dst[n][k] = *(const LAS bf16x8*)(lds + PG8_SB(b, h) + boff + n * 2048 + k * 1024); } while (0)
#define PG8_MMA(ai, bj, At, Bt) do { __builtin_amdgcn_s_setprio(1); _Pragma("unroll") for (int m = 0; m < 4; ++m) _Pragma("unroll") for (int n = 0; n < 2; ++n) _Pragma("unroll") for (int k = 0; k < 2; ++k) \
        acc[ai][bj][m][n] = __builtin_amdgcn_mfma_f32_16x16x32_bf16(Bt[n][k], At[m][k], acc[ai][bj][m][n], 0, 0, 0); __builtin_amdgcn_s_setprio(0); } while (0)
#define PG8_WAIT_V(n) asm volatile("s_waitcnt vmcnt(" #n ")" ::: "memory")
#define PG8_WAIT_L(n) asm volatile("s_waitcnt lgkmcnt(" #n ")" ::: "memory")
#define PG8_BAR __builtin_amdgcn_s_barrier()
#define PG8_SCHED __builtin_amdgcn_sched_barrier(0)
    Unit cur, nxt; int ui = 0;
    if (!S.next(0, cur)) return;
    f32x4 acc[2][2][4][2];
#pragma unroll
    for (int a = 0; a < 2; ++a)
#pragma unroll
        for (int b = 0; b < 2; ++b)
#pragma unroll
            for (int m = 0; m < 4; ++m)
#pragma unroll
                for (int n = 0; n < 2; ++n) acc[a][b][m][n] = (f32x4){0.f, 0.f, 0.f, 0.f};
    bf16x8 At[4][2], B0[2][2], B1[2][2];
    const char* cA = (const char*)g.A + (size_t)cur.pm * tstep + (size_t)cur.kc * cstep; const char* cB = (const char*)g.Bt + (size_t)cur.pn * tstep + (size_t)cur.kc * cstep;
    PG8_STAGE(PG8_SB(0, 0), cB, voffA); PG8_STAGE(PG8_SB(0, 1), cB + hstep, voffA); PG8_STAGE(PG8_SA(0, 0), cA, voffA); PG8_STAGE(PG8_SA(0, 1), cA + hstep, voffA);
    if (wr == 1) PG8_BAR;
    PG8_WAIT_V(2); PG8_BAR;
    PG8_STAGE(PG8_SB(1, 0), cB + kstep, voffA); PG8_STAGE(PG8_SA(1, 0), cA + kstep, voffA); PG8_STAGE(PG8_SB(1, 1), cB + hstep + kstep, voffA);
    PG8_WAIT_V(6); PG8_BAR;
    for (;;) {
        const bool has_next = S.next(ui + 1, nxt);
        const char* nA = has_next ? (const char*)g.A + (size_t)nxt.pm * tstep + (size_t)nxt.kc * cstep : cA; const char* nB = has_next ? (const char*)g.Bt + (size_t)nxt.pn * tstep + (size_t)nxt.kc * cstep : cB;
        for (int t = 0; t < nt; t += 2) {
            const bool last = (t == nt - 2);
            const char* a1 = cA + (size_t)(t + 1) * kstep;
            const char* a2 = last ? nA : cA + (size_t)(t + 2) * kstep; const char* b2 = last ? nB : cB + (size_t)(t + 2) * kstep;
            const char* a3 = a2 + kstep; const char* b3 = b2 + kstep;
            PG8_LDB(B0, 0, 0); PG8_LDB(B1, 0, 1); PG8_SCHED; PG8_LDA(At, 0, 0); PG8_STAGE(PG8_SA(1, 1), a1 + hstep, voffA);
            PG8_WAIT_V(8); PG8_WAIT_L(0); PG8_BAR; PG8_MMA(0, 0, At, B0); PG8_MMA(0, 1, At, B1); PG8_BAR; PG8_SCHED;
            PG8_LDA(At, 0, 1); PG8_STAGE(PG8_SB(0, 0), b2, voffA); PG8_STAGE(PG8_SB(0, 1), b2 + hstep, voffA); PG8_STAGE(PG8_SA(0, 0), a2, voffA);
            PG8_WAIT_V(8); PG8_WAIT_L(0); PG8_BAR; PG8_MMA(1, 0, At, B0); PG8_MMA(1, 1, At, B1); PG8_BAR; PG8_SCHED;
            PG8_LDB(B0, 1, 0); PG8_LDB(B1, 1, 1); PG8_SCHED; PG8_LDA(At, 1, 0); PG8_STAGE(PG8_SA(0, 1), a2 + hstep, voffA);
            PG8_WAIT_V(8); PG8_WAIT_L(0); PG8_BAR; PG8_MMA(0, 0, At, B0); PG8_MMA(0, 1, At, B1); PG8_BAR; PG8_SCHED;
            PG8_LDA(At, 1, 1); PG8_STAGE(PG8_SB(1, 0), b3, voffA); PG8_STAGE(PG8_SB(1, 1), b3 + hstep, voffA); PG8_STAGE(PG8_SA(1, 0), a3, voffA);
            PG8_WAIT_V(8); PG8_WAIT_L(0); PG8_BAR; PG8_MMA(1, 0, At, B0); PG8_MMA(1, 1, At, B1); PG8_BAR; PG8_SCHED;
        }
        if (wr == 0) PG8_BAR;
        E(acc, cur, wr, wc, fr, fq);
        if (!has_next) break;
#pragma unroll
        for (int a = 0; a < 2; ++a)
#pragma unroll
            for (int b = 0; b < 2; ++b)
#pragma unroll
                for (int m = 0; m < 4; ++m)
#pragma unroll
                    for (int n = 0; n < 2; ++n) acc[a][b][m][n] = (f32x4){0.f, 0.f, 0.f, 0.f};
        cur = nxt; cA = nA; cB = nB; ++ui;
        if (wr == 1) PG8_BAR;
    }
    PG8_WAIT_V(0);
    PG8_BAR;
#undef PG8_SA
#undef PG8_SB
#undef PG8_STAGE
#undef PG8_LDA
#undef PG8_LDB
#undef PG8_MMA
#undef PG8_WAIT_V
#undef PG8_WAIT_L
#undef PG8_BAR
#undef PG8_SCHED
}
}
using pg8::Unit;
typedef const f32x4 (&AccRef)[2][2][4][2];

struct EpiAda {
    float* mods; const float* bias;
    DEV void operator()(AccRef acc, const Unit& u, int wr, int wc, int fr, int fq) const {
        if (u.pm != 0 || wr != 0) return;
#pragma unroll
        for (int m = 0; m < 2; ++m) { const int r = 16 * m + fr;
#pragma unroll
            for (int bj = 0; bj < 2; ++bj)
#pragma unroll
                for (int n = 0; n < 2; ++n) { const int c = u.pn * 256 + bj * 128 + wc * 32 + n * 16 + 4 * fq;
                    const f32x4 bv = *(const f32x4*)(bias + c); *(f32x4*)(mods + (size_t)r * NMODS + c) = acc[0][bj][m][n] + bv; } }
    }
};
struct EpiSwiglu {
    bf16_t* G;
    DEV void operator()(AccRef acc, const Unit& u, int wr, int wc, int fr, int fq) const {
        const int hc = 128 * u.pn + 32 * wc + 8 * fq;
#pragma unroll
        for (int ai = 0; ai < 2; ++ai)
#pragma unroll
            for (int m = 0; m < 4; ++m) { const int r = u.pm * 256 + ai * 128 + wr * 64 + m * 16 + fr;
                const f32x4 a0 = acc[ai][0][m][0], a1 = acc[ai][0][m][1], b0 = acc[ai][1][m][0], b1 = acc[ai][1][m][1];
                u32x4 w; w.x = cvt_pk_bf16(siluf_(a0[0]) * b0[0], siluf_(a0[1]) * b0[1]); w.y = cvt_pk_bf16(siluf_(a0[2]) * b0[2], siluf_(a0[3]) * b0[3]);
                w.z = cvt_pk_bf16(siluf_(a1[0]) * b1[0], siluf_(a1[1]) * b1[1]); w.w = cvt_pk_bf16(siluf_(a1[2]) * b1[2], siluf_(a1[3]) * b1[3]);
                *(u32x4*)(G + (size_t)r * FF + hc) = w; }
    }
};
struct EpiResid {
    const float* xp; const float* xs; float* out; const float* gate; float scale; int from_input;
    DEV void operator()(AccRef acc, const Unit& u, int wr, int wc, int fr, int fq) const {
#pragma unroll
        for (int ai = 0; ai < 2; ++ai)
#pragma unroll
            for (int m = 0; m < 4; ++m) { const int r = u.pm * 256 + ai * 128 + wr * 64 + m * 16 + fr; const int bi = brow(r);
                const float* xin = from_input ? (r < MP ? xp + (size_t)r * DM : xs + (size_t)(r - MP) * DM) : out + (size_t)r * DM;
                float* xo = out + (size_t)r * DM; const float* gp = gate + (size_t)bi * NMODS;
#pragma unroll
                for (int bj = 0; bj < 2; ++bj)
#pragma unroll
                    for (int n = 0; n < 2; ++n) { const int c = u.pn * 256 + bj * 128 + wc * 32 + n * 16 + 4 * fq;
                        const f32x4 xv = *(const f32x4*)(xin + c), gv = *(const f32x4*)(gp + c);
                        *(f32x4*)(xo + c) = xv + (gv + 1.f) * scale * acc[ai][bj][m][n]; }
                asm volatile("" ::: "memory"); }
    }
};
struct EpiPartial {
    float* part;
    DEV void operator()(AccRef acc, const Unit& u, int wr, int wc, int fr, int fq) const {
#pragma unroll
        for (int ai = 0; ai < 2; ++ai)
#pragma unroll
            for (int m = 0; m < 4; ++m) { const int rl = (u.pm - 256) * 256 + ai * 128 + wr * 64 + m * 16 + fr; float* rowp = part + ((size_t)u.kc * 512 + rl) * DM;
#pragma unroll
                for (int bj = 0; bj < 2; ++bj)
#pragma unroll
                    for (int n = 0; n < 2; ++n) { const int c = u.pn * 256 + bj * 128 + wc * 32 + n * 16 + 4 * fq; *(f32x4*)(rowp + c) = acc[ai][bj][m][n]; } }
    }
};
struct EpiBf16 {
    bf16_t* O; int ldo;
    DEV void operator()(AccRef acc, const Unit& u, int wr, int wc, int fr, int fq) const {
#pragma unroll
        for (int ai = 0; ai < 2; ++ai)
#pragma unroll
            for (int m = 0; m < 4; ++m) { const int r = u.pm * 256 + ai * 128 + wr * 64 + m * 16 + fr; bf16_t* rowp = O + (size_t)r * ldo;
#pragma unroll
                for (int bj = 0; bj < 2; ++bj) { const int c = u.pn * 256 + bj * 128 + wc * 32 + 8 * fq; const f32x4 a = acc[ai][bj][m][0], b = acc[ai][bj][m][1];
                    u32x4 w; w.x = cvt_pk_bf16(a[0], a[1]); w.y = cvt_pk_bf16(a[2], a[3]); w.z = cvt_pk_bf16(b[0], b[1]); w.w = cvt_pk_bf16(b[2], b[3]); *(u32x4*)(rowp + c) = w; } }
    }
};
struct EpiLora {
    float* decay; bf16_t* abuf; bf16_t* gbuf; const float* w0; const float* a0;
    DEV void operator()(AccRef acc, const Unit& u, int wr, int wc, int fr, int fq) const {
        const int seg = u.pn >> 1; const int cb = (u.pn & 1) * 256 + wc * 32 + 8 * fq;
        const float* bias = seg == 0 ? w0 : a0; bf16_t* ob = seg == 1 ? abuf : gbuf;
#pragma unroll
        for (int ai = 0; ai < 2; ++ai)
#pragma unroll
            for (int m = 0; m < 4; ++m) { const int r = u.pm * 256 + ai * 128 + wr * 64 + m * 16 + fr;
#pragma unroll
                for (int bj = 0; bj < 2; ++bj) { const int c = cb + bj * 128; f32x4 a = acc[ai][bj][m][0], b = acc[ai][bj][m][1];
                    if (seg < 2) { a = a + *(const f32x4*)(bias + c); b = b + *(const f32x4*)(bias + c + 4); }
                    if (seg == 0) { *(f32x4*)(decay + (size_t)r * 512 + c) = a; *(f32x4*)(decay + (size_t)r * 512 + c + 4) = b; }
                    else { if (seg == 1) {
#pragma unroll
                            for (int e = 0; e < 4; ++e) { a[e] = sigmoidf_(a[e]); b[e] = sigmoidf_(b[e]); } }
                        u32x4 w; w.x = cvt_pk_bf16(a[0], a[1]); w.y = cvt_pk_bf16(a[2], a[3]); w.z = cvt_pk_bf16(b[0], b[1]); w.w = cvt_pk_bf16(b[2], b[3]); *(u32x4*)(ob + (size_t)r * 512 + c) = w; } }
                asm volatile("" ::: "memory"); }
    }
};
struct EpiGlu {
    const bf16_t* ya; bf16_t* yb;
    DEV void operator()(AccRef acc, const Unit& u, int wr, int wc, int fr, int fq) const {
#pragma unroll
        for (int ai = 0; ai < 2; ++ai)
#pragma unroll
            for (int m = 0; m < 4; ++m) { const int r = u.pm * 256 + ai * 128 + wr * 64 + m * 16 + fr;
#pragma unroll
                for (int bj = 0; bj < 2; ++bj) { const int c = u.pn * 256 + bj * 128 + wc * 32 + 8 * fq; const f32x4 a = acc[ai][bj][m][0], b = acc[ai][bj][m][1];
                    const u32x4 yv = *(const u32x4*)(ya + (size_t)r * 512 + c);
                    u32x4 w; w.x = cvt_pk_bf16(bflo(yv.x) * sigmoidf_(a[0]), bfhi(yv.x) * sigmoidf_(a[1])); w.y = cvt_pk_bf16(bflo(yv.y) * sigmoidf_(a[2]), bfhi(yv.y) * sigmoidf_(a[3]));
                    w.z = cvt_pk_bf16(bflo(yv.z) * sigmoidf_(b[0]), bfhi(yv.z) * sigmoidf_(b[1])); w.w = cvt_pk_bf16(bflo(yv.w) * sigmoidf_(b[2]), bfhi(yv.w) * sigmoidf_(b[3]));
                    *(u32x4*)(yb + (size_t)r * DM + c) = w; } }
    }
};

struct Job { const float* s0; const float* s1; int ld, K, Nd, mode; bf16_t* dst; };
DEV Job get_job(CP p, int j) {
    Job J; J.s1 = nullptr; J.mode = 0; bf16_t* W = (bf16_t*)(p.ws + OFF_W);
    if (j < 2) { J.s0 = p.in[9] + (size_t)j * 1024 * 9216; J.ld = 9216; J.K = 1024; J.Nd = 9216; J.dst = (bf16_t*)(p.ws + OFF_B + B_ADA) + (size_t)j * 9216 * 1024; }
    else if (j < 6) { const int q = j - 2, l = q >> 1, f = q & 1; J.s0 = p.in[f ? 17 : 14] + (size_t)l * 1024 * FF; J.s1 = p.in[f ? 18 : 15] + (size_t)l * 1024 * FF;
        J.ld = FF; J.K = 1024; J.Nd = 5632; J.mode = 1; J.dst = (bf16_t*)((unsigned char*)W + W_UP + q * SZ_UP); }
    else if (j < 10) { const int q = j - 6, l = q >> 1, f = q & 1; J.s0 = p.in[f ? 19 : 16] + (size_t)l * FF * 1024; J.ld = 1024; J.K = FF; J.Nd = 1024; J.dst = (bf16_t*)((unsigned char*)W + W_DN + q * SZ_DN); }
    else if (j == 10) { J.s0 = p.in[20]; J.ld = 2304; J.K = 1024; J.Nd = 2304; J.mode = 3; J.dst = (bf16_t*)((unsigned char*)W + W_ABIN); }
    else if (j == 11) { J.s0 = p.in[21]; J.ld = 1024; J.K = 1024; J.Nd = 1024; J.dst = (bf16_t*)((unsigned char*)W + W_ABOUT); }
    else if (j == 12) { J.s0 = p.in[30]; J.ld = 512; J.K = 512; J.Nd = 512; J.mode = 3; J.dst = (bf16_t*)((unsigned char*)W + W_GLU); }
    else if (j == 13) { J.s0 = p.in[33]; J.ld = 512; J.K = 256; J.Nd = 1536; J.mode = 2; J.dst = (bf16_t*)((unsigned char*)W + W_LORA); }
    else if (j == 14) { J.s0 = p.in[42]; J.ld = 4096; J.K = 1024; J.Nd = 4096; J.mode = 3; J.dst = (bf16_t*)((unsigned char*)W + W_CIN); }
    else { J.s0 = p.in[43]; J.ld = 1024; J.K = 1024; J.Nd = 1024; J.dst = (bf16_t*)((unsigned char*)W + W_COUT); }
    return J;
}
DEV void tr_load(CP p, const Job& J, int item, int lane, float (&v)[64]) {
    const int nblk = J.Nd / 64, kb = item / nblk, nb = item % nblk, k0 = 64 * kb, n0 = 64 * nb;
    const float* src = J.s0; int col = n0 + lane; bool valid = true; int krel0 = k0;
    const int rho = lane & 31, p32 = 8 * ((rho & 15) >> 2) + 4 * (rho >> 4) + (rho & 3);
    if (J.mode == 1) { const int n = n0 + lane, within = n & 255; col = 128 * (n >> 8) + 32 * ((within >> 5) & 3) + p32; src = (within >> 7) ? J.s1 : J.s0; }
    else if (J.mode == 3) { col = n0 + (lane & 32) + p32; }
    else if (J.mode == 2) { const int seg = n0 >> 9; col = ((n0 + (lane & 32)) & 511) + p32; src = seg == 0 ? p.in[33] : (seg == 1 ? p.in[35] : p.in[36]);
        valid = (seg == 0 && kb == 0) || (seg == 1 && kb == 1) || (seg == 2 && kb >= 2); krel0 = k0 - (seg == 0 ? 0 : (seg == 1 ? 64 : 128)); }
    const float* sp = src + (size_t)krel0 * J.ld + col;
#pragma unroll
    for (int i = 0; i < 64; ++i) v[i] = valid ? __builtin_nontemporal_load(sp + (size_t)i * J.ld) : 0.f;
}
DEV void tr_store(const Job& J, int item, LAS unsigned* scr, int lane, const float (&v)[64]) {
    const int nblk = J.Nd / 64, kb = item / nblk, nb = item % nblk, k0 = 64 * kb, n0 = 64 * nb;
#pragma unroll
    for (int i = 0; i < 32; ++i) scr[lane * 34 + i] = cvt_pk_bf16(v[2 * i], v[2 * i + 1]);
    asm volatile("s_waitcnt lgkmcnt(0)" ::: "memory");
#pragma unroll
    for (int j = 0; j < 8; ++j) { const int q = j * 64 + lane, n = q >> 3, c = q & 7;
        const u32x2 a = *(const LAS u32x2*)(scr + n * 34 + 4 * c), b = *(const LAS u32x2*)(scr + n * 34 + 4 * c + 2);
        *(u32x4*)(J.dst + (size_t)(n0 + n) * J.K + k0 + 8 * c) = (u32x4){a.x, a.y, b.x, b.y}; }
    asm volatile("s_waitcnt lgkmcnt(0)" ::: "memory");
}
DEV bool tr_decode(CP p, int idx, Job& J, int& item) {
    for (int j = 0; j < 16; ++j) { J = get_job(p, j); const int nit = (J.K / 64) * (J.Nd / 64); if (idx < nit) { item = idx; return true; } idx -= nit; }
    return false;
}
DEV void phase_prologue(CP p, LAS unsigned char* lds) {
    const int tid = tid_(), wave = tid >> 6, lane = tid & 63;
    LAS unsigned* scr = (LAS unsigned*)(lds + wave * 8704);
    const int gw = __builtin_amdgcn_readfirstlane(bid_() * 8 + wave), NW = gdim_() * 8;
    { int idx = gw; Job Jc; int ic = 0; bool vc = tr_decode(p, idx, Jc, ic); float v[64];
      if (vc) tr_load(p, Jc, ic, lane, v);
      while (vc) {
          idx += NW; Job Jn; int in_ = 0; const bool vn = tr_decode(p, idx, Jn, in_); float w[64];
          if (vn) tr_load(p, Jn, in_, lane, w);
          tr_store(Jc, ic, scr, lane, v);
          Jc = Jn; ic = in_; vc = vn;
#pragma unroll
          for (int i = 0; i < 64; ++i) v[i] = w[i];
      } }
    const int gt = bid_() * 512 + tid, NT = gdim_() * 512;
    bf16_t* acs = (bf16_t*)(p.ws + OFF_ACS);
    for (int i = gt; i < 256 * 1024; i += NT) { const int r = i >> 10, c = i & 1023; float v = 0.f;
        if (r < 16) v = siluf_(p.in[7][r * 1024 + c]); else if (r < 32) v = siluf_(p.in[8][(r - 16) * 1024 + c]);
        acs[i] = f2bf(v); }
    float* tab = (float*)(p.ws + OFF_TAB);
    for (int i = gt; i < 2048; i += NT) { const int g = i >> 6;
        const float dt = expf(p.in[24][g]), lr = p.in[22][i], li = p.in[23][i];
        const float mag = expf(lr * dt), th = li * dt, cs = cosf(th), sn = sinf(th), sh = sinf(0.5f * th);
        const float abr = mag * cs, abi = mag * sn;
        const float abr1 = expm1f(lr * dt) - 2.f * mag * sh * sh;
        const float den = lr * lr + li * li;
        const float zr = (abr1 * lr + abi * li) / den, zi = (abi * lr - abr1 * li) / den;
        tab[T_AB + 2 * i] = abr; tab[T_AB + 2 * i + 1] = abi;
#pragma unroll
        for (int h = 0; h < 16; ++h) { const float br = p.in[25][i * 16 + h], bi = p.in[26][i * 16 + h];
            tab[T_BBRE + i * 16 + h] = zr * br - zi * bi; tab[T_BBIM + i * 16 + h] = zr * bi + zi * br; } }
    for (int i = gt; i < 1024; i += NT) tab[T_LB + i] = 1.f / (1.f + expf(p.in[44][i] - p.in[44][1024 + i]));
}

DEV void phase_norm(CP p, int l, int which, int from_input, int fix, int fix_from_input, int fixn, float fixs) {
    const int tid = tid_(), wave = tid >> 6, lane = tid & 63, gw = bid_() * 8 + wave, NW = gdim_() * 8;
    const float* gamma = p.in[11 + which] + l * 1024;
    const float* mods = (const float*)(p.ws + OFF_MODS) + l * 9216 + 3 * which * 1024;
    bf16_t* H = (bf16_t*)(p.ws + OFF_H);
    f32x4 g4[4];
#pragma unroll
    for (int j = 0; j < 4; ++j) g4[j] = *(const f32x4*)(gamma + (lane + 64 * j) * 4);
    for (int r0 = gw * 2; r0 < MT; r0 += NW * 2) {
        f32x4 v[2][4];
#pragma unroll
        for (int u = 0; u < 2; ++u) { const int r = r0 + u;
            const bool fx = fix >= 0 && r >= MP;
            const float* xr = (from_input || (fx && fix_from_input)) ? (r < MP ? p.in[0] + (size_t)r * DM : p.in[1] + (size_t)(r - MP) * DM) : p.out + (size_t)r * DM;
#pragma unroll
            for (int j = 0; j < 4; ++j) v[u][j] = __builtin_nontemporal_load((const f32x4*)(xr + (lane + 64 * j) * 4));
            if (fx) { const float* part = (const float*)(p.ws + OFF_B + B_PART) + (size_t)(r - MP) * DM; const float* gp = (const float*)(p.ws + OFF_MODS) + (size_t)brow(r) * NMODS + fix;
#pragma unroll
                for (int j = 0; j < 4; ++j) { const int c = (lane + 64 * j) * 4; f32x4 sm = *(const f32x4*)(part + c);
                    for (int kc = 1; kc < fixn; ++kc) sm = sm + *(const f32x4*)(part + (size_t)kc * 512 * DM + c);
                    v[u][j] = v[u][j] + (*(const f32x4*)(gp + c) + 1.f) * fixs * sm; *(f32x4*)(p.out + (size_t)r * DM + c) = v[u][j]; } } }
#pragma unroll
        for (int u = 0; u < 2; ++u) { const int r = r0 + u; float ss = 0.f;
#pragma unroll
            for (int j = 0; j < 4; ++j) ss += (v[u][j][0] * v[u][j][0] + v[u][j][1] * v[u][j][1]) + (v[u][j][2] * v[u][j][2] + v[u][j][3] * v[u][j][3]);
            const float rstd = rsqrtf(wave_sum(ss) * (1.f / 1024.f) + 1e-6f);
            const float* mp = mods + (size_t)brow(r) * NMODS;
#pragma unroll
            for (int j = 0; j < 4; ++j) { const int c = (lane + 64 * j) * 4; const f32x4 sh = *(const f32x4*)(mp + c), sc = *(const f32x4*)(mp + 1024 + c);
                const f32x4 h = v[u][j] * rstd * g4[j] * (sc + 1.f) + sh;
                u32x2 w; w.x = cvt_pk_bf16(h[0], h[1]); w.y = cvt_pk_bf16(h[2], h[3]); *(u32x2*)(H + (size_t)r * DM + c) = w; } }
    }
}
DEV void phase_final_norm(CP p, int fix) {
    const int tid = tid_(), wave = tid >> 6, lane = tid & 63, gw = bid_() * 8 + wave, NW = gdim_() * 8;
    const float* gamma = p.in[46];
    f32x4 g4[4];
#pragma unroll
    for (int j = 0; j < 4; ++j) g4[j] = *(const f32x4*)(gamma + (lane + 64 * j) * 4);
    for (int r0 = gw * 2; r0 < MT; r0 += NW * 2) {
        f32x4 v[2][4];
#pragma unroll
        for (int u = 0; u < 2; ++u) { const int r = r0 + u; const float* xr = p.out + (size_t)r * DM;
#pragma unroll
            for (int j = 0; j < 4; ++j) v[u][j] = __builtin_nontemporal_load((const f32x4*)(xr + (lane + 64 * j) * 4));
            if (r >= MP) { const float* part = (const float*)(p.ws + OFF_B + B_PART) + (size_t)(r - MP) * DM; const float* gp = (const float*)(p.ws + OFF_MODS) + (size_t)brow(r) * NMODS + fix;
#pragma unroll
                for (int j = 0; j < 4; ++j) { const int c = (lane + 64 * j) * 4; f32x4 sm = *(const f32x4*)(part + c);
                    for (int kc = 1; kc < 11; ++kc) sm = sm + *(const f32x4*)(part + (size_t)kc * 512 * DM + c);
                    v[u][j] = v[u][j] + (*(const f32x4*)(gp + c) + 1.f) * 0.5f * sm; } } }
#pragma unroll
        for (int u = 0; u < 2; ++u) { float* xr = p.out + (size_t)(r0 + u) * DM; float ss = 0.f;
#pragma unroll
            for (int j = 0; j < 4; ++j) ss += (v[u][j][0] * v[u][j][0] + v[u][j][1] * v[u][j][1]) + (v[u][j][2] * v[u][j][2] + v[u][j][3] * v[u][j][3]);
            const float rstd = rsqrtf(wave_sum(ss) * (1.f / 1024.f) + 1e-6f);
#pragma unroll
            for (int j = 0; j < 4; ++j) __builtin_nontemporal_store(v[u][j] * rstd * g4[j], (f32x4*)(xr + (lane + 64 * j) * 4)); }
    }
}

DEV void phase_even_prep(CP p) {
    const int tid = tid_(), wave = tid >> 6, lane = tid & 63, gw = bid_() * 8 + wave, NW = gdim_() * 8;
    const bf16_t* P = (const bf16_t*)(p.ws + OFF_B + B_P);
    bf16_t* LA = (bf16_t*)(p.ws + OFF_B + B_LORA);
    const int j4 = lane * 4, cidx = 1536 + j4;
    const f32x4 mu = *(const f32x4*)(p.in[31] + cidx);
    #pragma unroll 1
    for (int r0 = gw * 2; r0 < MT; r0 += NW * 2) {
        u32x2 cu[2], pu[2]; f32x4 sp[2];
#pragma unroll
        for (int u = 0; u < 2; ++u) { const int r = r0 + u; const bool smp = r >= MP; const int t = smp ? ((r - MP) & 31) : (r & 4095);
            cu[u] = *(const u32x2*)(P + (size_t)r * LDP_E + 512 + cidx);
            if (t > 0) pu[u] = *(const u32x2*)(P + (size_t)(r - 1) * LDP_E + 512 + cidx);
            else if (smp) sp[u] = *(const f32x4*)(p.in[5] + ((r - MP) >> 5) * 1792 + cidx); }
#pragma unroll
        for (int u = 0; u < 2; ++u) { const int r = r0 + u; const bool smp = r >= MP; const int t = smp ? ((r - MP) & 31) : (r & 4095);
            const f32x4 cur = (f32x4){bflo(cu[u].x), bfhi(cu[u].x), bflo(cu[u].y), bfhi(cu[u].y)};
            f32x4 prev;
            if (t > 0) prev = (f32x4){bflo(pu[u].x), bfhi(pu[u].x), bflo(pu[u].y), bfhi(pu[u].y)}; else if (smp) prev = sp[u]; else prev = (f32x4){0.f, 0.f, 0.f, 0.f};
            const f32x4 ps = cur + (prev - cur) * mu; f32x4 o;
#pragma unroll
            for (int e = 0; e < 4; ++e) { const float x = ps[e]; o[e] = lane < 16 ? (1.f - 2.f / (1.f + __expf(2.f * x))) : (lane < 32 ? x : sigmoidf_(x)); }
            u32x2 w; w.x = cvt_pk_bf16(o[0], o[1]); w.y = cvt_pk_bf16(o[2], o[3]);
            *(u32x2*)(LA + (size_t)r * 256 + j4) = w; }
    }
    const int gt = bid_() * 512 + tid, NT = gdim_() * 512;
    for (int i = gt; i < 2 * 16 * 1792; i += NT) { const int s = i / (16 * 1792), rem = i % (16 * 1792), b = rem / 1792, c = rem % 1792;
        const int row = s ? MP + b * 32 + 31 : b * 4096 + 4095;
        p.out[(s ? O_SHIFT_S : O_SHIFT_P) + (size_t)b * 1792 + c] = bf2f(P[(size_t)row * LDP_E + 512 + c]); }
}

template <bool STORE>
DEV void s5_pass(CP p, LAS unsigned char* lds) {
    const int tid = tid_(), wave = tid >> 6, lane = tid & 63, li = lane & 15, lq = lane >> 4;
    const int G32 = gdim_() >> 5; if ((int)bid_() >= G32 * 32) return;
    const int xcd_ = bid_() & 7, idx_ = bid_() >> 3, g = 4 * xcd_ + (idx_ & 3), slot = idx_ >> 2, ws0 = slot * 8 + wave, nws = G32 * 8;
    const float* tab = (const float*)(p.ws + OFF_TAB);
    const bf16_t* P = (const bf16_t*)(p.ws + OFF_B + B_P);
    float* E = (float*)(p.ws + OFF_S5E); float* ES = (float*)(p.ws + OFF_S5ES);
    bf16_t* YA = (bf16_t*)(p.ws + OFF_B + B_YA);
    float a1r[4], a1i[4], alr[4], ali[4], a16r[4], a16i[4];
#pragma unroll
    for (int pc = 0; pc < 4; ++pc) { const float ar = tab[T_AB + 2 * (g * 64 + 16 * pc + li)], ai = tab[T_AB + 2 * (g * 64 + 16 * pc + li) + 1];
        const float r2 = ar * ar - ai * ai, i2 = 2.f * ar * ai, r4 = r2 * r2 - i2 * i2, i4 = 2.f * r2 * i2, r8 = r4 * r4 - i4 * i4, i8 = 2.f * r4 * i4;
        const float r12 = r8 * r4 - i8 * i4, i12 = r8 * i4 + i8 * r4;
        a1r[pc] = ar; a1i[pc] = ai; a16r[pc] = r8 * r8 - i8 * i8; a16i[pc] = 2.f * r8 * i8;
        alr[pc] = lq == 0 ? 1.f : (lq == 1 ? r4 : (lq == 2 ? r8 : r12)); ali[pc] = lq == 0 ? 0.f : (lq == 1 ? i4 : (lq == 2 ? i8 : i12)); }
    bf16x8 bfrag[8];
#pragma unroll
    for (int cb = 0; cb < 8; ++cb) { u32x4 w = (u32x4){0u, 0u, 0u, 0u};
        if (lq < 2) { const float* src = tab + ((cb >> 2) ? T_BBIM : T_BBRE) + (g * 64 + 16 * (cb & 3) + li) * 16 + 8 * lq; const f32x4 c0 = *(const f32x4*)src, c1 = *(const f32x4*)(src + 4);
            w.x = cvt_pk_bf16(c0[0], c0[1]); w.y = cvt_pk_bf16(c0[2], c0[3]); w.z = cvt_pk_bf16(c1[0], c1[1]); w.w = cvt_pk_bf16(c1[2], c1[3]); }
        bfrag[cb] = __builtin_bit_cast(bf16x8, w); }
    const int h = li, kq = lq;
    bf16x8 bfr[4]; float dsk = 0.f;
    if (STORE) {
        dsk = p.in[29][g * 16 + h];
#pragma unroll
        for (int kk = 0; kk < 4; ++kk) { const int k = kk * 32 + kq * 8; const bool im = k >= 64; const float* src = (im ? p.in[28] : p.in[27]) + (size_t)(g * 16 + h) * 64 + (k & 63);
            const f32x4 c0 = *(const f32x4*)src, c1 = *(const f32x4*)(src + 4); const float sg = im ? -1.f : 1.f;
            u32x4 w; w.x = cvt_pk_bf16(sg * c0[0], sg * c0[1]); w.y = cvt_pk_bf16(sg * c0[2], sg * c0[3]); w.z = cvt_pk_bf16(sg * c1[0], sg * c1[1]); w.w = cvt_pk_bf16(sg * c1[2], sg * c1[3]);
            bfr[kk] = __builtin_bit_cast(bf16x8, w); }
    }
    LAS bf16_t* xs = (LAS bf16_t*)(lds + wave * 4352);
    u32x4 nafr[4];
#define S5_FETCH(rs) do { const int rs_ = (rs); \
        _Pragma("unroll") for (int q = 0; q < 4; ++q) nafr[q] = (u32x4){0u, 0u, 0u, 0u}; \
        if (rs_ < 1024 + 16) { int row0_, T_; \
            if (rs_ < 1024) { const int b_ = rs_ >> 6, c_ = rs_ & 63; row0_ = b_ * 4096 + c_ * 64; T_ = 64; } \
            else { const int b_ = rs_ - 1024; row0_ = MP + b_ * 32; T_ = 32; } \
            if (lq < 2) { _Pragma("unroll") for (int q = 0; q < 4; ++q) if (16 * q < T_) nafr[q] = *(const u32x4*)(P + (size_t)(row0_ + 16 * q + li) * LDP_E + g * 16 + 8 * lq); } } } while (0)
    S5_FETCH(ws0);
    for (int rest = ws0; rest < 1024 + 16; rest += nws) {
        int row0, T; size_t eidx;
        if (rest < 1024) { const int b = rest >> 6, c = rest & 63; row0 = b * 4096 + c * 64; T = 64; eidx = ((size_t)(b * 32 + g) * 64 + c) * 128; }
        else { const int b = rest - 1024; row0 = MP + b * 32; T = 32; eidx = (size_t)(b * 32 + g) * 128; }
        float hr[4], hi[4]; u32x4 afr[4];
#pragma unroll
        for (int q = 0; q < 4; ++q) { afr[q] = nafr[q]; hr[q] = 0.f; hi[q] = 0.f;
            if (STORE) { if (rest < 1024) { hr[q] = E[eidx + 16 * q + li]; hi[q] = E[eidx + 64 + 16 * q + li]; } else { hr[q] = p.in[2][(rest - 1024) * 2048 + g * 64 + 16 * q + li]; hi[q] = p.in[3][(rest - 1024) * 2048 + g * 64 + 16 * q + li]; } } }
        S5_FETCH(rest + nws);
#pragma unroll 1
        for (int blk = 0; blk < T / 16; ++blk) { {
            const bf16x8 acur = __builtin_bit_cast(bf16x8, afr[0]); afr[0] = afr[1]; afr[1] = afr[2]; afr[2] = afr[3];
            f32x4 D[8];
#pragma unroll
            for (int cb = 0; cb < 8; ++cb) D[cb] = __builtin_amdgcn_mfma_f32_16x16x32_bf16(acur, bfrag[cb], (f32x4){0.f, 0.f, 0.f, 0.f}, 0, 0, 0);
#pragma unroll
            for (int pc = 0; pc < 4; ++pc) {
                float xr[4], xi[4];
                xr[0] = D[pc][0]; xi[0] = D[pc + 4][0];
#pragma unroll
                for (int r = 1; r < 4; ++r) { xr[r] = a1r[pc] * xr[r - 1] - a1i[pc] * xi[r - 1] + D[pc][r]; xi[r] = a1r[pc] * xi[r - 1] + a1i[pc] * xr[r - 1] + D[pc + 4][r]; }
                float er = xr[3], ei = xi[3];
                const float q2r = a1r[pc] * a1r[pc] - a1i[pc] * a1i[pc], q2i = 2.f * a1r[pc] * a1i[pc], q4r = q2r * q2r - q2i * q2i, q4i = 2.f * q2r * q2i, q8r = q4r * q4r - q4i * q4i, q8i = 2.f * q4r * q4i;
                { const float tr = __shfl_up(er, 16), ti = __shfl_up(ei, 16); if (lq >= 1) { er += q4r * tr - q4i * ti; ei += q4r * ti + q4i * tr; } }
                { const float tr = __shfl_up(er, 32), ti = __shfl_up(ei, 32); if (lq >= 2) { er += q8r * tr - q8i * ti; ei += q8r * ti + q8i * tr; } }
                float cr = __shfl_up(er, 16), ci = __shfl_up(ei, 16); if (lq == 0) { cr = 0.f; ci = 0.f; }
                const float nr = __shfl(er, 48 + li), ni = __shfl(ei, 48 + li);
                cr += alr[pc] * hr[pc] - ali[pc] * hi[pc]; ci += alr[pc] * hi[pc] + ali[pc] * hr[pc];
                const float h2r = nr + a16r[pc] * hr[pc] - a16i[pc] * hi[pc], h2i = ni + a16r[pc] * hi[pc] + a16i[pc] * hr[pc];
                hr[pc] = h2r; hi[pc] = h2i;
                if (STORE) {
#pragma unroll
                    for (int r = 0; r < 4; ++r) { const float yr = a1r[pc] * cr - a1i[pc] * ci, yi = a1r[pc] * ci + a1i[pc] * cr; cr = yr; ci = yi;
                        xs[(4 * lq + r) * 136 + 16 * pc + li] = f2bf(xr[r] + yr); xs[(4 * lq + r) * 136 + 64 + 16 * pc + li] = f2bf(xi[r] + yi); } }
            }
            if (STORE) {
                asm volatile("s_waitcnt lgkmcnt(0)" ::: "memory");
                f32x4 acc = (f32x4){0.f, 0.f, 0.f, 0.f};
#pragma unroll
                for (int kk = 0; kk < 4; ++kk) { const bf16x8 a = *(const LAS bf16x8*)(xs + h * 136 + kk * 32 + kq * 8); acc = __builtin_amdgcn_mfma_f32_16x16x32_bf16(a, bfr[kk], acc, 0, 0, 0); }
                asm volatile("s_waitcnt lgkmcnt(0)" ::: "memory");
#pragma unroll
                for (int r = 0; r < 4; ++r) { const int tt = blk * 16 + 4 * kq + r; const size_t row = (size_t)(row0 + tt);
                    const float uval = bf2f(P[row * LDP_E + g * 16 + h]); const float y = acc[r] + uval * dsk;
                    const float tz = 0.7978845608f * (y + 0.044715f * y * y * y); const float th = 1.f - 2.f * __builtin_amdgcn_rcpf(1.f + __builtin_amdgcn_exp2f(2.88539008f * tz)); const float ge = 0.5f * y * (1.f + th);
                    YA[row * 512 + g * 16 + h] = f2bf(ge); }
            }
        } }
        if (!STORE && lq == 0) {
#pragma unroll
            for (int q = 0; q < 4; ++q) { if (rest < 1024) { E[eidx + 16 * q + li] = hr[q]; E[eidx + 64 + 16 * q + li] = hi[q]; } else { ES[eidx + 16 * q + li] = hr[q]; ES[eidx + 64 + 16 * q + li] = hi[q]; } } }
    }
#undef S5_FETCH
}
DEV void s5_pass2(CP p) {
    const int gt = bid_() * 512 + tid_(), NT = gdim_() * 512;
    const float* tab = (const float*)(p.ws + OFF_TAB);
    float* E = (float*)(p.ws + OFF_S5E); const float* ES = (const float*)(p.ws + OFF_S5ES);
    for (int i = gt; i < 65536; i += NT) { const int smp = i >> 15, j = i & 32767, bg = j >> 6, pp = j & 63, g = bg & 31;
        float ar = tab[T_AB + 2 * (g * 64 + pp)], ai = tab[T_AB + 2 * (g * 64 + pp) + 1];
        const int nsq = smp ? 5 : 6;
        for (int s = 0; s < nsq; ++s) { const float nr = ar * ar - ai * ai, ni = 2.f * ar * ai; ar = nr; ai = ni; }
        if (!smp) { float cr = 0.f, ci = 0.f;
            for (int c = 0; c < 64; ++c) { const size_t e = ((size_t)bg * 64 + c) * 128; const float er = E[e + pp], ei = E[e + 64 + pp];
                E[e + pp] = cr; E[e + 64 + pp] = ci; const float nr = ar * cr - ai * ci + er, ni = ar * ci + ai * cr + ei; cr = nr; ci = ni; }
            p.out[O_S5RE_P + j] = cr; p.out[O_S5IM_P + j] = ci; }
        else { const float hr = p.in[2][j], hi = p.in[3][j]; const float er = ES[(size_t)bg * 128 + pp], ei = ES[(size_t)bg * 128 + 64 + pp];
            p.out[O_S5RE_S + j] = ar * hr - ai * hi + er; p.out[O_S5IM_S + j] = ar * hi + ai * hr + ei; } }
}

typedef float f32x2 __attribute__((ext_vector_type(2)));
#define LO2(v) __builtin_shufflevector(v, v, 0, 1)
#define HI2(v) __builtin_shufflevector(v, v, 2, 3)
DEV void rwkv_scan(CP p, LAS unsigned char* lds) {
    const int tid = tid_();
    const bf16_t* P = (const bf16_t*)(p.ws + OFF_B + B_P);
    const float* DEC = (const float*)(p.ws + OFF_B + B_DECAY); const bf16_t* AB = (const bf16_t*)(p.ws + OFF_B + B_ABUF);
    float* YR = (float*)(p.ws + OFF_B + B_YRAW);
    LAS float* bufs = (LAS float*)lds;
    const int rloc = tid >> 4, kq = tid & 15, ch = tid & 63, tsub = tid >> 6;
    for (int item = bid_(); item < 512; item += gdim_()) {
        const int smp = item >> 8, it = item & 255, b = it >> 4, h = (it >> 1) & 7, half = it & 1;
        const int L = smp ? 32 : 4096, row0 = smp ? MP + b * 32 : b * 4096, nch = L / 32;
        const int row = half * 32 + rloc, cidx = h * 64 + ch;
        f32x2 S01, S23;
        if (smp) { const f32x4 s = *(const f32x4*)(p.in[4] + ((size_t)(b * 8 + h) * 64 + row) * 64 + 4 * kq); S01 = LO2(s); S23 = HI2(s); }
        else { S01 = (f32x2){0.f, 0.f}; S23 = S01; }
        const float mu_r = p.in[31][cidx], mu_k = p.in[31][512 + cidx], mu_v = p.in[31][1024 + cidx], kkc = p.in[37][cidx], kac = p.in[38][cidx];
        float sp0 = 0.f, sp1 = 0.f, sp2 = 0.f;
        if (smp) { const float* sp = p.in[5] + b * 1792 + cidx; sp0 = sp[0]; sp1 = sp[512]; sp2 = sp[1024]; }
        bf16_t rh[4][7]; float rd[4];
        __syncthreads();
#define RW_LOAD(c) do { _Pragma("unroll") for (int i = 0; i < 4; ++i) { const int t = (c) * 32 + i * 8 + tsub; const size_t gr = (size_t)(row0 + t); \
            const bf16_t* pc = P + gr * LDP_E + 512 + cidx; const bf16_t* pp = pc - (t > 0 ? LDP_E : 0); \
            rh[i][0] = pc[0]; rh[i][1] = pc[512]; rh[i][2] = pc[1024]; rh[i][3] = pp[0]; rh[i][4] = pp[512]; rh[i][5] = pp[1024]; \
            rh[i][6] = AB[gr * 512 + cidx]; rd[i] = DEC[gr * 512 + cidx]; } } while (0)
#define RW_PROC(buf, c) do { _Pragma("unroll") for (int i = 0; i < 4; ++i) { const int tl = i * 8 + tsub; const bool first = ((c) * 32 + tl) == 0; \
            const float cr_ = bf2f(rh[i][0]), ck_ = bf2f(rh[i][1]), cv_ = bf2f(rh[i][2]); \
            const float pr_ = first ? sp0 : bf2f(rh[i][3]), pk_ = first ? sp1 : bf2f(rh[i][4]), pv_ = first ? sp2 : bf2f(rh[i][5]); \
            const float r = cr_ + (pr_ - cr_) * mu_r, k = ck_ + (pk_ - ck_) * mu_k, v = cv_ + (pv_ - cv_) * mu_v, a = bf2f(rh[i][6]); \
            float kk = k * kkc; float n2 = red16(kk * kk); n2 += __shfl_xor(n2, 16); n2 += __shfl_xor(n2, 32); kk = kk * __builtin_amdgcn_rsqf(fmaxf(n2, 1e-24f)); \
            LAS float* bp = (buf) + tl * 64 + ch; bp[0] = r; bp[2048] = k * (1.f + (a - 1.f) * kac); bp[4096] = v; \
            { const float z = -rd[i]; const float sp = fmaxf(z, 0.f) + 0.69314718f * __builtin_amdgcn_logf(1.f + __builtin_amdgcn_exp2f(-1.44269504f * fabsf(z))); bp[6144] = __builtin_amdgcn_exp2f(-1.44269504f * __builtin_amdgcn_exp2f(-1.44269504f * (sp + 0.5f))); } \
            bp[8192] = -kk; bp[10240] = kk * a; } } while (0)
        RW_LOAD(0); RW_PROC(bufs, 0);
        __syncthreads();
        for (int c = 0; c < nch; ++c) {
            const LAS float* cb = bufs + (c & 1) * 12288 + 4 * kq;
            const LAS float* vb = bufs + (c & 1) * 12288 + 4096 + row;
            if (c + 1 < nch) RW_LOAD(c + 1);
            f32x4 r4 = *(const LAS f32x4*)(cb), k4 = *(const LAS f32x4*)(cb + 2048), w4 = *(const LAS f32x4*)(cb + 6144), a4 = *(const LAS f32x4*)(cb + 8192), b4 = *(const LAS f32x4*)(cb + 10240);
            float vv = vb[0];
#pragma unroll
            for (int tb = 0; tb < 2; ++tb) {
                float yp[16];
#pragma unroll
                for (int t16 = 0; t16 < 16; ++t16) {
                    const int tn = (tb * 16 + t16 + 1) & 31;
                    const f32x4 nr4 = *(const LAS f32x4*)(cb + tn * 64), nk4 = *(const LAS f32x4*)(cb + 2048 + tn * 64), nw4 = *(const LAS f32x4*)(cb + 6144 + tn * 64),
                                na4 = *(const LAS f32x4*)(cb + 8192 + tn * 64), nb4 = *(const LAS f32x4*)(cb + 10240 + tn * 64);
                    const float nvv = vb[tn * 64];
                    const f32x2 t2 = S01 * LO2(a4) + S23 * HI2(a4);
                    const f32x2 vv2 = (f32x2){vv, vv};
                    const f32x2 u01 = S01 * LO2(w4) + vv2 * LO2(k4), u23 = S23 * HI2(w4) + vv2 * HI2(k4);
                    const float sa = red16(t2.x + t2.y);
                    const f32x2 sa2 = (f32x2){sa, sa};
                    S01 = sa2 * LO2(b4) + u01; S23 = sa2 * HI2(b4) + u23;
                    const f32x2 y2 = S01 * LO2(r4) + S23 * HI2(r4);
                    yp[t16] = y2.x + y2.y;
                    r4 = nr4; k4 = nk4; w4 = nw4; a4 = na4; b4 = nb4; vv = nvv;
                }
                float yq[8], yr[4];
#pragma unroll
                for (int i = 0; i < 8; ++i) { const float keep = (kq & 1) ? yp[2 * i + 1] : yp[2 * i], send = (kq & 1) ? yp[2 * i] : yp[2 * i + 1]; yq[i] = keep + dppf<0xB1>(send); }
#pragma unroll
                for (int i = 0; i < 4; ++i) { const float keep = (kq & 2) ? yq[2 * i + 1] : yq[2 * i], send = (kq & 2) ? yq[2 * i] : yq[2 * i + 1]; yr[i] = keep + dppf<0x4E>(send); }
#pragma unroll
                for (int i = 0; i < 4; ++i) { yr[i] += dppf<0x124>(yr[i]); yr[i] += dppf<0x128>(yr[i]); }
                const float ysel = (kq >> 2) == 0 ? yr[0] : ((kq >> 2) == 1 ? yr[1] : ((kq >> 2) == 2 ? yr[2] : yr[3]));
                YR[(size_t)(row0 + c * 32 + tb * 16 + kq) * 512 + h * 64 + row] = ysel;
            }
            if (c + 1 < nch) RW_PROC(bufs + ((c + 1) & 1) * 12288, c + 1);
            __syncthreads();
        }
#undef RW_LOAD
#undef RW_PROC
        float* so = p.out + (smp ? O_RWKV_S : O_RWKV_P) + ((size_t)(b * 8 + h) * 64 + row) * 64 + 4 * kq;
        *(f32x4*)so = (f32x4){S01.x, S01.y, S23.x, S23.y};
    }
}
DEV void rwkv_post(CP p) {
    const int tid = tid_(), wave = tid >> 6, lane = tid & 63, gw = bid_() * 8 + wave, NW = gdim_() * 8;
    const bf16_t* P = (const bf16_t*)(p.ws + OFF_B + B_P);
    const bf16_t* AB = (const bf16_t*)(p.ws + OFF_B + B_ABUF); const bf16_t* GB = (const bf16_t*)(p.ws + OFF_B + B_GBUF);
    const float* YR = (const float*)(p.ws + OFF_B + B_YRAW);
    bf16_t* YB = (bf16_t*)(p.ws + OFF_H);
    const int hq = lane >> 4, j4 = (lane & 15) * 4;
    f32x4 mur[2], muk[2], muv[2], kac[2], rkc[2], lg[2], lb[2];
#pragma unroll
    for (int ps = 0; ps < 2; ++ps) { const int c = (hq + 4 * ps) * 64 + j4;
        mur[ps] = *(const f32x4*)(p.in[31] + c); muk[ps] = *(const f32x4*)(p.in[31] + 512 + c); muv[ps] = *(const f32x4*)(p.in[31] + 1024 + c);
        kac[ps] = *(const f32x4*)(p.in[38] + c); rkc[ps] = *(const f32x4*)(p.in[39] + c); lg[ps] = *(const f32x4*)(p.in[40] + c); lb[ps] = *(const f32x4*)(p.in[41] + c); }
    for (int r = gw; r < MT; r += NW) {
        const bool smp = r >= MP; const int t = smp ? ((r - MP) & 31) : (r & 4095);
        u32x2 cr[2], ck[2], cv[2], qr[2], qk[2], qv[2], av[2], gv[2]; f32x4 yv[2], sr[2], sk[2], sv[2];
#pragma unroll
        for (int ps = 0; ps < 2; ++ps) { const int c = (hq + 4 * ps) * 64 + j4; const bf16_t* pc = P + (size_t)r * LDP_E + 512 + c;
            cr[ps] = *(const u32x2*)pc; ck[ps] = *(const u32x2*)(pc + 512); cv[ps] = *(const u32x2*)(pc + 1024);
            if (t > 0) { const bf16_t* pp = pc - LDP_E; qr[ps] = *(const u32x2*)pp; qk[ps] = *(const u32x2*)(pp + 512); qv[ps] = *(const u32x2*)(pp + 1024); }
            else if (smp) { const float* sp = p.in[5] + ((r - MP) >> 5) * 1792 + c; sr[ps] = *(const f32x4*)sp; sk[ps] = *(const f32x4*)(sp + 512); sv[ps] = *(const f32x4*)(sp + 1024); }
            av[ps] = *(const u32x2*)(AB + (size_t)r * 512 + c); gv[ps] = *(const u32x2*)(GB + (size_t)r * 512 + c); yv[ps] = *(const f32x4*)(YR + (size_t)r * 512 + c); }
#pragma unroll
        for (int ps = 0; ps < 2; ++ps) { const int c = (hq + 4 * ps) * 64 + j4;
            const f32x4 fr = (f32x4){bflo(cr[ps].x), bfhi(cr[ps].x), bflo(cr[ps].y), bfhi(cr[ps].y)}, fk = (f32x4){bflo(ck[ps].x), bfhi(ck[ps].x), bflo(ck[ps].y), bfhi(ck[ps].y)},
                        fv = (f32x4){bflo(cv[ps].x), bfhi(cv[ps].x), bflo(cv[ps].y), bfhi(cv[ps].y)};
            f32x4 pr, pk, pv;
            if (t > 0) { pr = (f32x4){bflo(qr[ps].x), bfhi(qr[ps].x), bflo(qr[ps].y), bfhi(qr[ps].y)}; pk = (f32x4){bflo(qk[ps].x), bfhi(qk[ps].x), bflo(qk[ps].y), bfhi(qk[ps].y)};
                         pv = (f32x4){bflo(qv[ps].x), bfhi(qv[ps].x), bflo(qv[ps].y), bfhi(qv[ps].y)}; }
            else if (smp) { pr = sr[ps]; pk = sk[ps]; pv = sv[ps]; }
            else { pr = (f32x4){0.f, 0.f, 0.f, 0.f}; pk = pr; pv = pr; }
            const f32x4 rr = fr + (pr - fr) * mur[ps], k0 = fk + (pk - fk) * muk[ps], vv = fv + (pv - fv) * muv[ps];
            const f32x4 a = (f32x4){bflo(av[ps].x), bfhi(av[ps].x), bflo(av[ps].y), bfhi(av[ps].y)}, g = (f32x4){bflo(gv[ps].x), bfhi(gv[ps].x), bflo(gv[ps].y), bfhi(gv[ps].y)};
            const f32x4 km = k0 * ((a - 1.f) * kac[ps] + 1.f);
            const f32x4 y = yv[ps];
            const float mean = red16((y[0] + y[1]) + (y[2] + y[3])) * (1.f / 64.f);
            const f32x4 d = y - mean;
            const float var = red16((d[0] * d[0] + d[1] * d[1]) + (d[2] * d[2] + d[3] * d[3])) * (1.f / 64.f);
            const f32x4 bb = rr * km * rkc[ps];
            const float bonus = red16((bb[0] + bb[1]) + (bb[2] + bb[3]));
            const f32x4 o = (d * rsqrtf(var + 64e-5f) * lg[ps] + lb[ps] + vv * bonus) * g;
            u32x2 w; w.x = cvt_pk_bf16(o[0], o[1]); w.y = cvt_pk_bf16(o[2], o[3]);
            *(u32x2*)(YB + (size_t)r * DM + 512 + c) = w; }
    }
}

DEV void hgrn_scan(CP p, LAS unsigned char* lds) {
    const int tid = tid_();
    const bf16_t* P = (const bf16_t*)(p.ws + OFF_B);
    float* OR = (float*)(p.ws + OFF_B + B_ORAW);
    const float* lbt = (const float*)(p.ws + OFF_TAB) + T_LB;
    LAS float* bufs = (LAS float*)lds;
    const int cp = tid >> 4, kq = tid & 15, ch = tid & 127, tsub = tid >> 7, tv = tid >> 4, cv = (tid & 15) * 4;
    for (int item = bid_(); item < 512; item += gdim_()) {
        const int smp = item >> 8, it = item & 255, b = it >> 4, h = (it >> 1) & 7, half = it & 1;
        const int L = smp ? 32 : 4096, row0 = smp ? MP + b * 32 : b * 4096, nch = L / 32;
        const int col = half * 64 + 2 * cp;
        f32x2 S[8];
#pragma unroll
        for (int j = 0; j < 8; ++j) S[j] = smp ? *(const f32x2*)(p.in[6] + ((size_t)(b * 8 + h) * 128 + 8 * kq + j) * 128 + col) : (f32x2){0.f, 0.f};
        const float lb = lbt[h * 128 + ch], oml = 1.f - lb;
        bf16_t rq[8], rf[8]; u32x2 rv;
        __syncthreads();
#define HG_LOAD(c) do { _Pragma("unroll") for (int i = 0; i < 8; ++i) { const int t = (c) * 32 + i * 4 + tsub; const bf16_t* pc = P + (size_t)(row0 + t) * LDP_O + h * 128 + ch; \
            rq[i] = pc[0]; rf[i] = pc[1024]; } \
            rv = *(const u32x2*)(P + (size_t)(row0 + (c) * 32 + tv) * LDP_O + 2048 + h * 128 + half * 64 + cv); } while (0)
#define HG_PROC(buf) do { _Pragma("unroll") for (int i = 0; i < 8; ++i) { const int tl = i * 4 + tsub; (buf)[tl * 128 + ch] = siluf_(bf2f(rq[i])); (buf)[4096 + tl * 128 + ch] = oml * sigmoidf_(-bf2f(rf[i])); } \
            *(LAS f32x4*)((buf) + 8192 + tv * 64 + cv) = (f32x4){bflo(rv.x), bfhi(rv.x), bflo(rv.y), bfhi(rv.y)}; } while (0)
        HG_LOAD(0); HG_PROC(bufs);
        __syncthreads();
        for (int c = 0; c < nch; ++c) {
            const LAS float* qb = bufs + (c & 1) * 10240 + 8 * kq;
            const LAS float* vb = bufs + (c & 1) * 10240 + 8192 + 2 * cp;
            if (c + 1 < nch) HG_LOAD(c + 1);
            f32x4 q0 = *(const LAS f32x4*)(qb), q1 = *(const LAS f32x4*)(qb + 4), k0 = *(const LAS f32x4*)(qb + 4096), k1 = *(const LAS f32x4*)(qb + 4100);
            f32x2 v2 = *(const LAS f32x2*)(vb);
#pragma unroll 1
            for (int tb = 0; tb < 2; ++tb) {
                f32x2 osel = (f32x2){0.f, 0.f};
#pragma unroll
                for (int t16 = 0; t16 < 16; ++t16) {
                    const int tn = (tb * 16 + t16 + 1) & 31;
                    const f32x4 nq0 = *(const LAS f32x4*)(qb + tn * 128), nq1 = *(const LAS f32x4*)(qb + tn * 128 + 4), nk0 = *(const LAS f32x4*)(qb + 4096 + tn * 128), nk1 = *(const LAS f32x4*)(qb + 4100 + tn * 128);
                    const f32x2 nv2 = *(const LAS f32x2*)(vb + tn * 64);
                    f32x2 oa = (f32x2){0.f, 0.f}, ob = oa;
#pragma unroll
                    for (int e = 0; e < 4; ++e) {
                        S[e] = S[e] + (v2 - S[e]) * k0[e]; oa = oa + S[e] * q0[e];
                        S[4 + e] = S[4 + e] + (v2 - S[4 + e]) * k1[e]; ob = ob + S[4 + e] * q1[e]; }
                    const f32x2 o2 = oa + ob;
                    const float ox = red16(o2.x), oy = red16(o2.y);
                    osel = (kq == t16) ? (f32x2){ox, oy} : osel;
                    q0 = nq0; q1 = nq1; k0 = nk0; k1 = nk1; v2 = nv2;
                }
                *(f32x2*)(OR + (size_t)(row0 + c * 32 + tb * 16 + kq) * DM + h * 128 + col) = osel;
            }
            if (c + 1 < nch) HG_PROC(bufs + ((c + 1) & 1) * 10240);
            __syncthreads();
        }
#undef HG_LOAD
#undef HG_PROC
        float* so = p.out + (smp ? O_HGRN_S : O_HGRN_P) + ((size_t)(b * 8 + h) * 128 + 8 * kq) * 128 + col;
#pragma unroll
        for (int j = 0; j < 8; ++j) *(f32x2*)(so + (size_t)j * 128) = S[j];
    }
}
#ifndef HC_WRITE_O
#define HC_WRITE_O 1
#endif
#ifndef HC_WRITE_S
#define HC_WRITE_S 1
#endif
#ifndef HC_SERIAL_FIRST
#define HC_SERIAL_FIRST 0
#endif
DEV void hgrn_chunk(CP p, LAS unsigned char* lds) {
    const int tid = tid_(), wave = __builtin_amdgcn_readfirstlane(tid >> 6), lane = tid & 63, li = lane & 15, lq = lane >> 4;
    const bf16_t* P = (const bf16_t*)(p.ws + OFF_B);
    bf16_t* YB = (bf16_t*)(p.ws + OFF_H);
    const float* lbt = (const float*)(p.ws + OFF_TAB) + T_LB;
    constexpr int SSQ = 32768 + 77824;
    constexpr int YT = 32768 + 78848;
    constexpr int HB = 32768, QT = HB + 0, KT = HB + 8704, KH = HB + 17408, VT = HB + 27648, AT = HB + 37888, ST = HB + 40448, TOT = HB + 75264, BL = HB + 77312;
    const int k = tid & 127, j = tid >> 7;
    for (int item = bid_(); item < 256; item += gdim_()) {
        const int smp = item >> 7, it = item & 127, b = it >> 3, h = it & 7;
        const int L = smp ? 32 : 4096, row0 = smp ? MP + b * 32 : b * 4096, nch = L / 32;
        const float lb = lbt[h * 128 + k], oml = 1.f - lb;
        const float gnv = p.in[45][16 * wave + li]; const int gsh = (li & 1) * 16;
        f32x4 acc[8];
#pragma unroll
        for (int vi = 0; vi < 8; ++vi)
#pragma unroll
            for (int r = 0; r < 4; ++r) acc[vi][r] = smp ? p.in[6][((size_t)(b * 8 + h) * 128 + 16 * wave + 4 * lq + r) * 128 + 16 * vi + li] : 0.f;
        __syncthreads();
#pragma unroll
        for (int vi = 0; vi < 8; ++vi) { u32x2 w; w.x = cvt_pk_bf16(acc[vi][0], acc[vi][1]); w.y = cvt_pk_bf16(acc[vi][2], acc[vi][3]);
            *(LAS u32x2*)(lds + ST + (16 * vi + li) * 272 + (16 * wave + 4 * lq) * 2) = w; }
        unsigned rq[8], rf[8], rv[8];
        const int ksh = (k & 1) * 16;
#define HC_LOAD(c) do { _Pragma("unroll") for (int i = 0; i < 8; ++i) { const unsigned* pc = (const unsigned*)(P + (size_t)(row0 + (c) * 32 + 8 * j + i) * LDP_O + h * 128 + (k & ~1)); rq[i] = pc[0]; rf[i] = pc[512]; rv[i] = pc[1024]; } } while (0)
#define HC_PICK(w) __uint_as_float(((w) >> ksh) << 16)
        HC_LOAD(0);
        for (int c = 0; c < nch; ++c) {
            float cs[8], kkv[8], qs[8]; float run = 1.f;
#pragma unroll
            for (int i = 0; i < 8; ++i) { const float f = HC_PICK(rf[i]); const float sg = __builtin_amdgcn_rcpf(1.f + __builtin_amdgcn_exp2f(-1.44269504f * f)); const float ft = lb + oml * sg; kkv[i] = oml * (1.f - sg);
                run *= ft; cs[i] = run; const float qv = HC_PICK(rq[i]); qs[i] = qv * __builtin_amdgcn_rcpf(1.f + __builtin_amdgcn_exp2f(-1.44269504f * qv)); }
            *(LAS float*)(lds + TOT + (j * 128 + k) * 4) = run;
            { u32x4 w; w.x = ((rv[0] >> ksh) & 0xffffu) | ((rv[1] >> ksh) << 16); w.y = ((rv[2] >> ksh) & 0xffffu) | ((rv[3] >> ksh) << 16); w.z = ((rv[4] >> ksh) & 0xffffu) | ((rv[5] >> ksh) << 16); w.w = ((rv[6] >> ksh) & 0xffffu) | ((rv[7] >> ksh) << 16);
              *(LAS u32x4*)(lds + VT + k * 80 + 16 * j) = w; }
            __syncthreads();
            if (c > 0) { const int t = tid >> 4, ch16 = tid & 15; const u32x4 yv = *(const LAS u32x4*)(lds + YT + t * 272 + ch16 * 16);
                *(u32x4*)(YB + (size_t)(row0 + (c - 1) * 32 + t) * DM + h * 128 + ch16 * 8) = yv; }
            if (c + 1 < nch) HC_LOAD(c + 1);
            float pre = 1.f, bl = 1.f;
#pragma unroll
            for (int jj = 0; jj < 4; ++jj) { const float tv = *(const LAS float*)(lds + TOT + (jj * 128 + k) * 4); bl *= tv; pre *= (jj < j) ? tv : 1.f; }
            const float ebl = bl;
            if (j == 0) *(LAS float*)(lds + BL + k * 4) = ebl;
            float khp[8];
#pragma unroll
            for (int i = 0; i < 8; ++i) { const float e = pre * cs[i]; const float ie = __builtin_amdgcn_rcpf(e); const int t = 8 * j + i;
                *(LAS bf16_t*)(lds + QT + t * 272 + k * 2) = f2bf(qs[i] * e); *(LAS bf16_t*)(lds + KT + t * 272 + k * 2) = f2bf(kkv[i] * ie); khp[i] = kkv[i] * (ebl * ie); }
            { u32x4 w; w.x = cvt_pk_bf16(khp[0], khp[1]); w.y = cvt_pk_bf16(khp[2], khp[3]); w.z = cvt_pk_bf16(khp[4], khp[5]); w.w = cvt_pk_bf16(khp[6], khp[7]);
              *(LAS u32x4*)(lds + KH + k * 80 + 16 * j) = w; }
            __syncthreads();
            if (wave < 4) { const int ti = wave >> 1, si = wave & 1; f32x4 a1 = (f32x4){0.f, 0.f, 0.f, 0.f};
                if (!(ti == 0 && si == 1)) {
#pragma unroll
                    for (int k4 = 0; k4 < 4; ++k4) { const bf16x8 a = *(const LAS bf16x8*)(lds + QT + (16 * ti + li) * 272 + (32 * k4 + 8 * lq) * 2), bb = *(const LAS bf16x8*)(lds + KT + (16 * si + li) * 272 + (32 * k4 + 8 * lq) * 2);
                        a1 = __builtin_amdgcn_mfma_f32_16x16x32_bf16(a, bb, a1, 0, 0, 0); } }
#pragma unroll
                for (int r = 0; r < 4; ++r) { const int t = 16 * ti + 4 * lq + r, sx = 16 * si + li; *(LAS bf16_t*)(lds + AT + t * 80 + sx * 2) = f2bf(t >= sx ? a1[r] : 0.f); } }
            __syncthreads();
            f32x4 oo[2]; unsigned gw_[2][4];
            { const bf16x8 bV = *(const LAS bf16x8*)(lds + VT + (16 * wave + li) * 80 + 16 * lq); bf16x8 bS[4]; f32x4 sq;
#pragma unroll
              for (int k4 = 0; k4 < 4; ++k4) bS[k4] = *(const LAS bf16x8*)(lds + ST + (16 * wave + li) * 272 + (32 * k4 + 8 * lq) * 2);
#pragma unroll
              for (int ti = 0; ti < 2; ++ti) {
#pragma unroll
                  for (int r = 0; r < 4; ++r) gw_[ti][r] = *(const unsigned*)(P + (size_t)(row0 + c * 32 + 16 * ti + 4 * lq + r) * LDP_O + 3072 + h * 128 + 16 * wave + (li & ~1)); }
#pragma unroll
              for (int ti = 0; ti < 2; ++ti) { f32x4 o = (f32x4){0.f, 0.f, 0.f, 0.f};
                  const bf16x8 aA = *(const LAS bf16x8*)(lds + AT + (16 * ti + li) * 80 + 16 * lq); o = __builtin_amdgcn_mfma_f32_16x16x32_bf16(aA, bV, o, 0, 0, 0);
#pragma unroll
                  for (int k4 = 0; k4 < 4; ++k4) { const bf16x8 aQ = *(const LAS bf16x8*)(lds + QT + (16 * ti + li) * 272 + (32 * k4 + 8 * lq) * 2); o = __builtin_amdgcn_mfma_f32_16x16x32_bf16(aQ, bS[k4], o, 0, 0, 0); }
#pragma unroll
                  for (int r = 0; r < 4; ++r) sq[r] = red16(o[r] * o[r]);
                  if (li == 0) *(LAS f32x4*)(lds + SSQ + (wave * 32 + 16 * ti + 4 * lq) * 4) = sq;
                  oo[ti] = o; } }
            { const bf16x8 aK = *(const LAS bf16x8*)(lds + KH + (16 * wave + li) * 80 + 16 * lq); const f32x4 sc = *(const LAS f32x4*)(lds + BL + (16 * wave + 4 * lq) * 4);
#pragma unroll
              for (int vi = 0; vi < 8; ++vi) { const bf16x8 bV = *(const LAS bf16x8*)(lds + VT + (16 * vi + li) * 80 + 16 * lq); acc[vi] = __builtin_amdgcn_mfma_f32_16x16x32_bf16(aK, bV, acc[vi] * sc, 0, 0, 0); } }
            __syncthreads();
#pragma unroll
            for (int vi = 0; vi < 8; ++vi) { u32x2 w; w.x = cvt_pk_bf16(acc[vi][0], acc[vi][1]); w.y = cvt_pk_bf16(acc[vi][2], acc[vi][3]);
                *(LAS u32x2*)(lds + ST + (16 * vi + li) * 272 + (16 * wave + 4 * lq) * 2) = w; }
#pragma unroll
            for (int ti = 0; ti < 2; ++ti) { f32x4 tot = *(const LAS f32x4*)(lds + SSQ + (16 * ti + 4 * lq) * 4);
#pragma unroll
                for (int w8 = 1; w8 < 8; ++w8) tot = tot + *(const LAS f32x4*)(lds + SSQ + (w8 * 32 + 16 * ti + 4 * lq) * 4);
#pragma unroll
                for (int r = 0; r < 4; ++r) { const float rstd = __builtin_amdgcn_rsqf(tot[r] * (1.f / 128.f) + 1e-6f); const float gt = __uint_as_float((gw_[ti][r] >> gsh) << 16);
                    *(LAS bf16_t*)(lds + YT + (16 * ti + 4 * lq + r) * 272 + (16 * wave + li) * 2) = f2bf(oo[ti][r] * rstd * gnv * siluf_(gt)); } }
        }
        __syncthreads();
        { const int t = tid >> 4, ch16 = tid & 15; const u32x4 yv = *(const LAS u32x4*)(lds + YT + t * 272 + ch16 * 16);
          *(u32x4*)(YB + (size_t)(row0 + (nch - 1) * 32 + t) * DM + h * 128 + ch16 * 8) = yv; }
#undef HC_LOAD
#undef HC_PICK
        float* so = p.out + (smp ? O_HGRN_S : O_HGRN_P) + (size_t)(b * 8 + h) * 128 * 128;
#pragma unroll
        for (int vi = 0; vi < 8; ++vi)
#pragma unroll
            for (int r = 0; r < 4; ++r) if (HC_WRITE_S) so[(size_t)(16 * wave + 4 * lq + r) * 128 + 16 * vi + li] = acc[vi][r];
    }
}
DEV void hgrn_post(CP p) {
    const int tid = tid_(), wave = tid >> 6, lane = tid & 63, gw = bid_() * 8 + wave, NW = gdim_() * 8;
    const bf16_t* P = (const bf16_t*)(p.ws + OFF_B);
    const float* OR = (const float*)(p.ws + OFF_B + B_ORAW);
    bf16_t* YB = (bf16_t*)(p.ws + OFF_H);
    const int hq = lane >> 4, j8 = (lane & 15) * 8;
    const f32x4 g0 = *(const f32x4*)(p.in[45] + j8), g1 = *(const f32x4*)(p.in[45] + j8 + 4);
    for (int r = gw; r < MT; r += NW) {
        f32x4 oa[2], ob[2]; u32x4 gg[2];
#pragma unroll
        for (int ps = 0; ps < 2; ++ps) { const int c = (hq + 4 * ps) * 128 + j8;
            oa[ps] = *(const f32x4*)(OR + (size_t)r * DM + c); ob[ps] = *(const f32x4*)(OR + (size_t)r * DM + c + 4); gg[ps] = *(const u32x4*)(P + (size_t)r * LDP_O + 3072 + c); }
#pragma unroll
        for (int ps = 0; ps < 2; ++ps) { const int c = (hq + 4 * ps) * 128 + j8; const f32x4 a = oa[ps], b = ob[ps];
            const float ss = red16(((a[0] * a[0] + a[1] * a[1]) + (a[2] * a[2] + a[3] * a[3])) + ((b[0] * b[0] + b[1] * b[1]) + (b[2] * b[2] + b[3] * b[3])));
            const float rstd = rsqrtf(ss * (1.f / 128.f) + 1e-6f);
            const f32x4 x = a * rstd * g0, y = b * rstd * g1;
            u32x4 w; w.x = cvt_pk_bf16(x[0] * siluf_(bflo(gg[ps].x)), x[1] * siluf_(bfhi(gg[ps].x))); w.y = cvt_pk_bf16(x[2] * siluf_(bflo(gg[ps].y)), x[3] * siluf_(bfhi(gg[ps].y)));
            w.z = cvt_pk_bf16(y[0] * siluf_(bflo(gg[ps].z)), y[1] * siluf_(bfhi(gg[ps].z))); w.w = cvt_pk_bf16(y[2] * siluf_(bflo(gg[ps].w)), y[3] * siluf_(bfhi(gg[ps].w)));
            *(u32x4*)(YB + (size_t)r * DM + c) = w; }
    }
}

__global__ __launch_bounds__(512, 2) void mega_fwd(Params p_unused) {
    extern __shared__ __attribute__((aligned(16))) unsigned char shm[];
    LAS unsigned char* lds = (LAS unsigned char*)shm;
    cg::grid_group grid = cg::this_grid();
    pg8::StaticOrder S;
    volatile LAS unsigned* xst = (volatile LAS unsigned*)(lds + 131072);
    if (threadIdx.x < 2) xst[threadIdx.x] = 0u;
    __syncthreads();
    const XcdBarrier XB = xcd_barrier_post((unsigned*)(PP.ws + OFF_BAR), xst);
#define GDIM (gdim_())
#define WSP(off) (p.ws + (off))

    if (PH_MASK & 1) phase_prologue(PP, lds);
    grid.sync();
    { CP p = PP; pg8::Gemm g{(const bf16_t*)WSP(OFF_ACS), (const bf16_t*)WSP(OFF_B + B_ADA), 256, NMODS, 1024, 1024}; S.init(256, NMODS, GDIM, bid_());
      EpiAda E{(float*)WSP(OFF_MODS), p.in[10]}; if (PH_MASK & 2) pg8::gemm_phase(lds, g, S, E); }
    xcd_barrier(XB);

    for (int st = 0; st < 6; ++st) {
        const int l = st / 3, kind = st % 3;
        if (kind != 1) {
            const int f = kind >> 1, q = l * 2 + f;
            if (PH_MASK & 4) phase_norm(PP, l, kind, st == 0, kind == 2 ? l * 9216 + 5 * 1024 : ((st == 3) ? 8 * 1024 : -1), 0, kind == 2 ? 4 : 11, kind == 2 ? 1.0f : 0.5f);
            xcd_barrier(XB);
            { CP p = PP; pg8::Gemm g{(const bf16_t*)WSP(OFF_H), (const bf16_t*)WSP(OFF_W + W_UP + q * SZ_UP), MT, 5632, 1024, 1024}; S.init(MT, 5632, GDIM, bid_());
              EpiSwiglu E{(bf16_t*)WSP(OFF_B)}; if (PH_MASK & 8) pg8::gemm_phase(lds, g, S, E); }
            xcd_barrier(XB);
            { CP p = PP; pg8::Gemm g{(const bf16_t*)WSP(OFF_B), (const bf16_t*)WSP(OFF_W + W_DN + q * SZ_DN), MP, 1024, FF, FF}; S.init(MP, 1024, GDIM, bid_());
              EpiResid E{p.in[0], p.in[1], p.out, (const float*)WSP(OFF_MODS) + l * 9216 + (3 * kind + 2) * 1024, 0.5f, st == 0}; if (PH_MASK & 16) pg8::gemm_phase(lds, g, S, E); }
            { CP p = PP; pg8::Gemm g{(const bf16_t*)WSP(OFF_B), (const bf16_t*)WSP(OFF_W + W_DN + q * SZ_DN), MT, 1024, 256, FF}; pg8::SplitOrder S2; S2.init(1024, 11, GDIM, bid_());
              EpiPartial E{(float*)WSP(OFF_B + B_PART)}; if (PH_MASK & 16) pg8::gemm_phase(lds, g, S2, E); }
            xcd_barrier(XB);
        } else {
            if (PH_MASK & 4) phase_norm(PP, l, 1, 0, l * 9216 + 2 * 1024, l == 0, 11, 0.5f);
            xcd_barrier(XB);
            { CP p = PP; const int N = l ? 4096 : 2304;
              pg8::Gemm g{(const bf16_t*)WSP(OFF_H), (const bf16_t*)WSP(OFF_W + (l ? W_CIN : W_ABIN)), MT, N, 1024, 1024}; S.init(MT, N, GDIM, bid_());
              EpiBf16 E{(bf16_t*)WSP(OFF_B), N}; if (PH_MASK & 32) pg8::gemm_phase(lds, g, S, E); }
            xcd_barrier(XB);
            if (l == 0) {
                if (PH_MASK & 64) phase_even_prep(PP);
                if (DBL_MASK & 64) phase_even_prep(PP);
                if (PH_MASK & 128) s5_pass<false>(PP, lds);
                xcd_barrier(XB);
                { CP p = PP; pg8::Gemm g{(const bf16_t*)WSP(OFF_B + B_LORA), (const bf16_t*)WSP(OFF_W + W_LORA), MT, 1536, 256, 256}; S.init(MT, 1536, GDIM, bid_());
                  EpiLora E{(float*)WSP(OFF_B + B_DECAY), (bf16_t*)WSP(OFF_B + B_ABUF), (bf16_t*)WSP(OFF_B + B_GBUF), p.in[32], p.in[34]}; if (PH_MASK & 256) pg8::gemm_phase(lds, g, S, E); }
                if (PH_MASK & 512) s5_pass2(PP);
                xcd_barrier(XB);
                if (PH_MASK & 1024) rwkv_scan(PP, lds);
                if (DBL_MASK & 1024) { __syncthreads(); rwkv_scan(PP, lds); }
                __syncthreads();
                if (PH_MASK & 2048) s5_pass<true>(PP, lds);
                if (DBL_MASK & 2048) { __syncthreads(); s5_pass<true>(PP, lds); }
                xcd_barrier(XB);
                { CP p = PP; pg8::Gemm g{(const bf16_t*)WSP(OFF_B + B_YA), (const bf16_t*)WSP(OFF_W + W_GLU), MT, 512, 512, 512}; S.init(MT, 512, GDIM, bid_());
                  EpiGlu E{(const bf16_t*)WSP(OFF_B + B_YA), (bf16_t*)WSP(OFF_H)}; if (PH_MASK & 4096) pg8::gemm_phase(lds, g, S, E); }
                if (PH_MASK & 8192) rwkv_post(PP);
                if (DBL_MASK & 8192) rwkv_post(PP);
                xcd_barrier(XB);
            } else {
                if (PH_MASK & 16384) hgrn_chunk(PP, lds);
                if (DBL_MASK & 16384) { __syncthreads(); hgrn_chunk(PP, lds); }
                xcd_barrier(XB);
            }
            { CP p = PP; pg8::Gemm g{(const bf16_t*)WSP(OFF_H), (const bf16_t*)WSP(OFF_W + (l ? W_COUT : W_ABOUT)), MP, 1024, 1024, 1024}; S.init(MP, 1024, GDIM, bid_());
              EpiResid E{p.in[0], p.in[1], p.out, (const float*)WSP(OFF_MODS) + l * 9216 + 5 * 1024, 1.0f, 0}; if (PH_MASK & 65536) pg8::gemm_phase(lds, g, S, E); }
            { CP p = PP; pg8::Gemm g{(const bf16_t*)WSP(OFF_H), (const bf16_t*)WSP(OFF_W + (l ? W_COUT : W_ABOUT)), MT, 1024, 256, 1024}; pg8::SplitOrder S2; S2.init(1024, 4, GDIM, bid_());
              EpiPartial E{(float*)WSP(OFF_B + B_PART)}; if (PH_MASK & 65536) pg8::gemm_phase(lds, g, S2, E); }
            xcd_barrier(XB);
        }
    }
    if (PH_MASK & 131072) phase_final_norm(PP, 9216 + 8 * 1024);
}

constexpr int LDS_BYTES = 131072 + 16;
extern "C" void kernel_launch(void* const* d_in, const int* in_sizes, int n_in, void* d_out, int out_size, void* d_ws, size_t ws_size, hipStream_t stream) {
    static int grid = 0;
    if (grid == 0) {
        if (n_in != 47 || (size_t)out_size != O_END || ws_size < WS_NEED) { fprintf(stderr, "kernel_launch: unexpected shapes: n_in %d out %d ws %zu (need %zu)\n", n_in, out_size, ws_size, (size_t)WS_NEED); grid = -1; return; }
        int dev = 0, cus = 0, per_cu = 0;
        hipGetDevice(&dev); hipDeviceGetAttribute(&cus, hipDeviceAttributeMultiprocessorCount, dev);
        if (hipFuncSetAttribute((const void*)mega_fwd, hipFuncAttributeMaxDynamicSharedMemorySize, LDS_BYTES) != hipSuccess) { fprintf(stderr, "kernel_launch: hipFuncSetAttribute failed\n"); grid = -1; return; }
        if (hipOccupancyMaxActiveBlocksPerMultiprocessor(&per_cu, (const void*)mega_fwd, 512, LDS_BYTES) != hipSuccess || per_cu < 1) { fprintf(stderr, "kernel_launch: occupancy query says %d\n", per_cu); per_cu = 1; }
        (void)hipGetLastError();
        grid = cus;
    }
    if (grid < 0) return;
    Params p{};
    for (int i = 0; i < 47; ++i) p.in[i] = (const float*)d_in[i];
    p.out = (float*)d_out; p.ws = (unsigned char*)d_ws;
    (void)hipMemsetAsync((char*)d_ws + OFF_BAR, 0, XCD_BAR_WORDS * sizeof(unsigned), stream);
    void* args[] = {&p};
    hipError_t e = hipLaunchCooperativeKernel((const void*)mega_fwd, dim3(grid), dim3(512), args, LDS_BYTES, stream);
    if (e != hipSuccess) fprintf(stderr, "cooperative launch failed: %s (grid %d)\n", hipGetErrorString(e), grid);
}
```

```cpp
#include <hip/hip_runtime.h>
#include <hip/hip_cooperative_groups.h>
#include <cstdio>
#include <cstdint>
namespace cg = cooperative_groups;

#define LAS __attribute__((address_space(3)))
#define DEV __device__ __forceinline__
typedef unsigned short bf16_t;
typedef short bf16x8 __attribute__((ext_vector_type(8)));
typedef float f32x4 __attribute__((ext_vector_type(4)));
typedef unsigned u32x4 __attribute__((ext_vector_type(4)));
typedef unsigned u32x2 __attribute__((ext_vector_type(2)));

constexpr int MT = 66048, MP = 65536, DM = 1024, FF = 2816, NMODS = 18432;
constexpr int LDP_E = 2304, LDP_O = 4096;
constexpr size_t O_Y = 0, O_S5RE_P = (size_t)MT * DM, O_S5IM_P = O_S5RE_P + 32768, O_RWKV_P = O_S5IM_P + 32768, O_SHIFT_P = O_RWKV_P + 524288,
                 O_HGRN_P = O_SHIFT_P + 28672, O_S5RE_S = O_HGRN_P + 2097152, O_S5IM_S = O_S5RE_S + 32768, O_RWKV_S = O_S5IM_S + 32768,
                 O_SHIFT_S = O_RWKV_S + 524288, O_HGRN_S = O_SHIFT_S + 28672, O_END = O_HGRN_S + 2097152;
constexpr size_t SZ_H = (size_t)MT * DM * 2;
constexpr size_t W_UP = 0, SZ_UP = (size_t)5632 * 1024 * 2, W_DN = W_UP + 4 * SZ_UP, SZ_DN = (size_t)1024 * 2816 * 2, W_ABIN = W_DN + 4 * SZ_DN,
                 W_ABOUT = W_ABIN + (size_t)2304 * 1024 * 2, W_GLU = W_ABOUT + (size_t)1024 * 1024 * 2, W_LORA = W_GLU + (size_t)512 * 512 * 2,
                 W_CIN = W_LORA + (size_t)1536 * 256 * 2, W_COUT = W_CIN + (size_t)4096 * 1024 * 2, SZ_W = W_COUT + (size_t)1024 * 1024 * 2;
constexpr size_t OFF_H = 0, OFF_W = OFF_H + SZ_H, OFF_MODS = OFF_W + SZ_W, OFF_ACS = OFF_MODS + (size_t)32 * NMODS * 4, OFF_TAB = OFF_ACS + (size_t)256 * 1024 * 2,
                 OFF_S5E = OFF_TAB + 294912, OFF_S5ES = OFF_S5E + (size_t)512 * 64 * 128 * 4, OFF_B = OFF_S5ES + (size_t)512 * 128 * 4;
constexpr size_t B_P = 0, B_LORA = B_P + (size_t)MT * 2304 * 2, B_DECAY = B_LORA + (size_t)MT * 256 * 2, B_ABUF = B_DECAY + (size_t)MT * 512 * 4,
                 B_GBUF = B_ABUF + (size_t)MT * 512 * 2, B_YA = B_GBUF + (size_t)MT * 512 * 2, B_YRAW = B_YA + (size_t)MT * 512 * 2, B_END = B_YRAW + (size_t)MT * 512 * 4;
constexpr size_t B_PART = 400000000;
constexpr size_t B_ADA = B_YRAW;
constexpr size_t B_ORAW = (size_t)MT * 4096 * 2;
constexpr size_t OFF_BAR = OFF_B + B_END;
constexpr size_t WS_NEED = OFF_BAR + 16384;
constexpr int T_AB = 0, T_BBRE = 4096, T_BBIM = T_BBRE + 32768, T_LB = T_BBIM + 32768;

#ifndef DBL_MASK
#define DBL_MASK 0
#endif
#ifndef PH_MASK
#define PH_MASK 0x3FFFF
#endif
struct Params { const float* in[47]; float* out; unsigned char* ws; };
typedef const __attribute__((address_space(4))) Params& CP;

DEV unsigned cvt_pk_bf16(float lo, float hi) { unsigned r; asm volatile("v_cvt_pk_bf16_f32 %0, %1, %2" : "=v"(r) : "v"(lo), "v"(hi)); return r; }
DEV float bf2f(bf16_t b) { return __uint_as_float(((unsigned)b) << 16); }
DEV float bflo(unsigned u) { return __uint_as_float(u << 16); }
DEV float bfhi(unsigned u) { return __uint_as_float(u & 0xffff0000u); }
DEV bf16_t f2bf(float f) { return (bf16_t)(cvt_pk_bf16(f, 0.f) & 0xffffu); }
DEV float wave_sum(float v) {
#pragma unroll
    for (int o = 1; o < 64; o <<= 1) v += __shfl_xor(v, o);
    return v;
}
template <int CTRL> DEV float dppf(float v) { return __int_as_float(__builtin_amdgcn_update_dpp(0, __float_as_int(v), CTRL, 0xF, 0xF, true)); }
DEV float red8(float v) { v += dppf<0xB1>(v); v += dppf<0x4E>(v); v += dppf<0x141>(v); return v; }
DEV float red16(float v) { v = red8(v); v += dppf<0x140>(v); return v; }
DEV float sigmoidf_(float x) { return __builtin_amdgcn_rcpf(1.f + __expf(-x)); }
DEV float siluf_(float x) { return x * __builtin_amdgcn_rcpf(1.f + __expf(-x)); }
DEV int tid_() { int t = threadIdx.x; asm volatile("" : "+v"(t)); return t; }
DEV int gdim_() { int g = gridDim.x; asm volatile("" : "+s"(g)); return g; }
DEV int bid_() { int b = blockIdx.x; asm volatile("" : "+s"(b)); return b; }
DEV const __attribute__((address_space(4))) Params* params_() { const __attribute__((address_space(4))) Params* q = (const __attribute__((address_space(4))) Params*)__builtin_amdgcn_kernarg_segment_ptr(); asm volatile("" : "+s"(q)); return q; }
#define PP (*params_())
DEV int brow(int r) { return r < MP ? (r >> 12) : 16 + ((r - MP) >> 5); }


#define XB_TMO      128
#define XB_XCNT(j)  (256  + 64 * (j))
#define XB_XSUB(j)  (1280 + 64 * (j))
#define XB_XGEN(j)  (2304 + 64 * (j))
#define XB_TOP      3328
#define XB_TOPGEN   3392
#define XCD_BAR_WORDS 3456
#define XB_SPIN_CAP (1u << 18)
DEV unsigned xb_ld(unsigned* p)              { return __hip_atomic_load(p, __ATOMIC_RELAXED, __HIP_MEMORY_SCOPE_AGENT); }
DEV unsigned xb_add(unsigned* p, unsigned v) { return __hip_atomic_fetch_add(p, v, __ATOMIC_RELAXED, __HIP_MEMORY_SCOPE_AGENT); }
DEV unsigned xb_xcc_id() { return (unsigned)__builtin_amdgcn_s_getreg((3 << 11) | 20) & 0xFu; }
#define XB_SPIN(cond, bar) do { unsigned _sp = 0; while (cond) { __builtin_amdgcn_s_sleep(1); \
    if ((++_sp & 255u) == 0u) { if (xb_ld(&(bar)[XB_TMO])) break; if (_sp > XB_SPIN_CAP) { atomicAdd(&(bar)[XB_TMO], 1u); break; } } } } while (0)
struct XcdBarrier { unsigned* bar; unsigned x; volatile LAS unsigned* st; };
DEV XcdBarrier xcd_barrier_post(unsigned* bar, volatile LAS unsigned* st) {
    XcdBarrier b; b.bar = bar; b.x = xb_xcc_id(); b.st = st;
    if (threadIdx.x == 0) (void)xb_add(&bar[XB_XCNT(b.x)], 1u);
    return b;
}
DEV void xcd_barrier_complete(unsigned* bar, unsigned x, unsigned& nloc, unsigned& nx) {
    const unsigned G = gridDim.x * gridDim.y * gridDim.z;
    unsigned sum, cnt, mine, sp = 0u;
    for (;;) {
        sum = 0u; cnt = 0u; mine = 0u;
#pragma unroll
        for (unsigned j = 0; j < 16; ++j) { const unsigned c = xb_ld(&bar[XB_XCNT(j)]); sum += c; cnt += (c > 0u) ? 1u : 0u; mine = (j == x) ? c : mine; }
        if (sum == G) break;
        __builtin_amdgcn_s_sleep(1);
        if ((++sp & 255u) == 0u) { if (xb_ld(&bar[XB_TMO])) break; if (sp > XB_SPIN_CAP) { atomicAdd(&bar[XB_TMO], 1u); break; } }
    }
    nloc = mine > 0u ? mine : 1u; nx = cnt > 0u ? cnt : 1u;
}
DEV void xcd_barrier(const XcdBarrier& b) {
    asm volatile("s_waitcnt vmcnt(0)" ::: "memory");
    __syncthreads();
    if (threadIdx.x == 0) {
        unsigned* bar = b.bar;
        __builtin_amdgcn_s_waitcnt(0);
        unsigned nloc = b.st[0], nx = b.st[1];
        if (nloc == 0u) { xcd_barrier_complete(bar, b.x, nloc, nx); b.st[0] = nloc; b.st[1] = nx; }
        const unsigned old = xb_add(&bar[XB_XSUB(b.x)], 1u);
        const unsigned gen = old / nloc;
        if (old + 1u == (gen + 1u) * nloc) {
            __builtin_amdgcn_fence(__ATOMIC_RELEASE, "agent");
            asm volatile("s_waitcnt vmcnt(0)" ::: "memory");
            const unsigned og = xb_add(&bar[XB_TOP], 1u);
            const unsigned tg = og / nx;
            if (og + 1u == (tg + 1u) * nx) xb_add(&bar[XB_TOPGEN], 1u);
            else XB_SPIN(xb_ld(&bar[XB_TOPGEN]) == tg, bar);
            __builtin_amdgcn_fence(__ATOMIC_ACQUIRE, "agent");
            xb_add(&bar[XB_XGEN(b.x)], 1u);
            asm volatile("s_waitcnt vmcnt(0)" ::: "memory");
        } else {
            XB_SPIN(xb_ld(&bar[XB_XGEN(b.x)]) == gen, bar);
            __builtin_amdgcn_fence(__ATOMIC_ACQUIRE, "agent");
            asm volatile("s_waitcnt vmcnt(0)" ::: "memory");
        }
    }
    __syncthreads();
}

namespace pg8 {
constexpr int BM = 256, BK = 64, HALF = 128, HTB = HALF * BK * 2, STAGE_BYTES = 8 * HTB, NXCD = 8, WGM = 8;
DEV int lds_byte(int r, int c) { const int st = (r >> 4) * 2 + (c >> 5), rr = r & 15, cc = c & 31, ob = rr * 64 + cc * 2; return st * 1024 + (ob ^ (((ob >> 9) & 1) << 5)); }
DEV void stage_rc(int b, int& R, int& C) { const int st = b / 1024, sb = b % 1024, swz = sb ^ (((sb >> 9) & 1) << 5); R = (st >> 1) * 16 + swz / 64; C = (st & 1) * 32 + (swz % 64) / 2; }
struct Unit { int pm, pn, kc; };
struct Gemm { const bf16_t* A; const bf16_t* Bt; int M, N, K, ld; };
struct StaticOrder {
    int nM, nN, nwg, G, c;
    DEV void init(int M, int N, int G_, int c_) { nM = M / BM; nN = N / BM; nwg = nM * nN; G = G_; c = c_; }
    DEV bool next(int i, Unit& u) const {
        const long L = (long)i * G + c; if (L >= nwg) return false;
        int wgid = (int)L; { const int q = nwg / NXCD, r = nwg % NXCD, xcd = wgid % NXCD, off = wgid / NXCD; wgid = (xcd < r ? xcd * (q + 1) : r * (q + 1) + (xcd - r) * q) + off; }
        const int nig = WGM * nN, gid = wgid / nig, fm = gid * WGM, gsz = (nM - fm) < WGM ? (nM - fm) : WGM;
        u.pm = fm + ((wgid % nig) % gsz); u.pn = (wgid % nig) / gsz; u.kc = 0; return true;
    }
};
struct SplitOrder {
    int nN, nkc, G, c;
    DEV void init(int N, int nkc_, int G_, int c_) { nN = N / BM; nkc = nkc_; G = G_; c = c_; }
    DEV bool next(int i, Unit& u) const {
        const int L = i * G + c; if (L >= 2 * nN * nkc) return false;
        const int rem = L % (2 * nN); u.kc = L / (2 * nN); u.pm = 256 + rem / nN; u.pn = rem % nN; return true;
    }
};
template <class Epi, class Sched>
DEV void gemm_phase(LAS unsigned char* lds, const Gemm g, const Sched& S, const Epi& E) {
    const int tid = tid_(), wid = __builtin_amdgcn_readfirstlane(tid >> 6), lane = tid & 63, wr = wid >> 2, wc = wid & 3, fr = lane & 15, fq = lane >> 4;
    int K = g.K; asm volatile("" : "+s"(K));
    const int nt = K / BK;
    int LD = g.ld; asm volatile("" : "+s"(LD));
    unsigned voffA[2];
#pragma unroll
    for (int i = 0; i < 2; ++i) { int R, C; stage_rc(tid * 16 + i * 8192, R, C); voffA[i] = (unsigned)(R * LD + C) * 2u; }
    const size_t kstep = (size_t)(BK * 2);
    const size_t hstep = (size_t)HALF * LD * 2;
    const size_t cstep = (size_t)K * 2;
    const size_t tstep = 2 * hstep;
    const unsigned ldsw = (unsigned)wid * 1024u;
    const int aoff = lds_byte(wr * 64 + fr, fq * 8), boff = lds_byte(wc * 32 + fr, fq * 8);
#define PG8_SA(b, h) (((b) * 2 + (h)) * HTB)
#define PG8_SB(b, h) ((4 + (b) * 2 + (h)) * HTB)
#define PG8_STAGE(bufoff, gbase, voff) do { _Pragma("unroll") for (int _i = 0; _i < 2; ++_i) \
        __builtin_amdgcn_global_load_lds((const unsigned*)((const char*)(gbase) + (voff)[_i]), (LAS unsigned*)(lds + (bufoff) + ldsw + _i * 8192), 16, 0, 0); } while (0)
#define PG8_LDA(dst, b, h) do { _Pragma("unroll") for (int m = 0; m < 4; ++m) _Pragma("unroll") for (int k = 0; k < 2; ++k) dst[m][k] = *(const LAS bf16x8*)(lds + PG8_SA(b, h) + aoff + m * 2048 + k * 1024); } while (0)
#define PG8_LDB(dst, b, h) do { _Pragma("unroll") for (int n = 0; n < 2; ++n) _Pragma("unroll") for (int k = 0; k < 2; ++k) dst[n][k] = *(const LAS bf16x8*)(lds + PG8_SB(b, h) + boff + n * 2048 + k * 1024); } while (0)
#define PG8_MMA(ai, bj, At, Bt) do { __builtin_amdgcn_s_setprio(1); _Pragma("unroll") for (int m = 0; m < 4; ++m) _Pragma("unroll") for (int n = 0; n < 2; ++n) _Pragma("unroll") for (int k = 0; k < 2; ++k) \
        acc[ai][bj][m][n] = __builtin_amdgcn_mfma_f32_16x16x32_bf16(Bt[n][k], At[m][k], acc[ai][bj][m][n], 0, 0, 0); __builtin_amdgcn_s_setprio(0); } while (0)
#define PG8_WAIT_V(n) asm volatile("s_waitcnt vmcnt(" #n ")" ::: "memory")
#define PG8_WAIT_L(n) asm volatile("s_waitcnt lgkmcnt(" #n ")" ::: "memory")
#define PG8_BAR __builtin_amdgcn_s_barrier()
#define PG8_SCHED __builtin_amdgcn_sched_barrier(0)
    Unit cur, nxt; int ui = 0;
    if (!S.next(0, cur)) return;
    f32x4 acc[2][2][4][2];
#pragma unroll
    for (int a = 0; a < 2; ++a)
#pragma unroll
        for (int b = 0; b < 2; ++b)
#pragma unroll
            for (int m = 0; m < 4; ++m)
#pragma unroll
                for (int n = 0; n < 2; ++n) acc[a][b][m][n] = (f32x4){0.f, 0.f, 0.f, 0.f};
    bf16x8 At[4][2], B0[2][2], B1[2][2];
    const char* cA = (const char*)g.A + (size_t)cur.pm * tstep + (size_t)cur.kc * cstep; const char* cB = (const char*)g.Bt + (size_t)cur.pn * tstep + (size_t)cur.kc * cstep;
    PG8_STAGE(PG8_SB(0, 0), cB, voffA); PG8_STAGE(PG8_SB(0, 1), cB + hstep, voffA); PG8_STAGE(PG8_SA(0, 0), cA, voffA); PG8_STAGE(PG8_SA(0, 1), cA + hstep, voffA);
    if (wr == 1) PG8_BAR;
    PG8_WAIT_V(2); PG8_BAR;
    PG8_STAGE(PG8_SB(1, 0), cB + kstep, voffA); PG8_STAGE(PG8_SA(1, 0), cA + kstep, voffA); PG8_STAGE(PG8_SB(1, 1), cB + hstep + kstep, voffA);
    PG8_WAIT_V(6); PG8_BAR;
    for (;;) {
        const bool has_next = S.next(ui + 1, nxt);
        const char* nA = has_next ? (const char*)g.A + (size_t)nxt.pm * tstep + (size_t)nxt.kc * cstep : cA; const char* nB = has_next ? (const char*)g.Bt + (size_t)nxt.pn * tstep + (size_t)nxt.kc * cstep : cB;
        for (int t = 0; t < nt; t += 2) {
            const bool last = (t == nt - 2);
            const char* a1 = cA + (size_t)(t + 1) * kstep;
            const char* a2 = last ? nA : cA + (size_t)(t + 2) * kstep; const char* b2 = last ? nB : cB + (size_t)(t + 2) * kstep;
            const char* a3 = a2 + kstep; const char* b3 = b2 + kstep;
            PG8_LDB(B0, 0, 0); PG8_LDB(B1, 0, 1); PG8_SCHED; PG8_LDA(At, 0, 0); PG8_STAGE(PG8_SA(1, 1), a1 + hstep, voffA);
            PG8_WAIT_V(8); PG8_WAIT_L(0); PG8_BAR; PG8_MMA(0, 0, At, B0); PG8_MMA(0, 1, At, B1); PG8_BAR; PG8_SCHED;
            PG8_LDA(At, 0, 1); PG8_STAGE(PG8_SB(0, 0), b2, voffA); PG8_STAGE(PG8_SB(0, 1), b2 + hstep, voffA); PG8_STAGE(PG8_SA(0, 0), a2, voffA);
            PG8_WAIT_V(8); PG8_WAIT_L(0); PG8_BAR; PG8_MMA(1, 0, At, B0); PG8_MMA(1, 1, At, B1); PG8_BAR; PG8_SCHED;
            PG8_LDB(B0, 1, 0); PG8_LDB(B1, 1, 1); PG8_SCHED; PG8_LDA(At, 1, 0); PG8_STAGE(PG8_SA(0, 1), a2 + hstep, voffA);
            PG8_WAIT_V(8); PG8_WAIT_L(0); PG8_BAR; PG8_MMA(0, 0, At, B0); PG8_MMA(0, 1, At, B1); PG8_BAR; PG8_SCHED;
            PG8_LDA(At, 1, 1); PG8_STAGE(PG8_SB(1, 0), b3, voffA); PG8_STAGE(PG8_SB(1, 1), b3 + hstep, voffA); PG8_STAGE(PG8_SA(1, 0), a3, voffA);
            PG8_WAIT_V(8); PG8_WAIT_L(0); PG8_BAR; PG8_MMA(1, 0, At, B0); PG8_MMA(1, 1, At, B1); PG8_BAR; PG8_SCHED;
        }
        if (wr == 0) PG8_BAR;
        E(acc, cur, wr, wc, fr, fq);
        if (!has_next) break;
#pragma unroll
        for (int a = 0; a < 2; ++a)
#pragma unroll
            for (int b = 0; b < 2; ++b)
#pragma unroll
                for (int m = 0; m < 4; ++m)
#pragma unroll
                    for (int n = 0; n < 2; ++n) acc[a][b][m][n] = (f32x4){0.f, 0.f, 0.f, 0.f};
        cur = nxt; cA = nA; cB = nB; ++ui;
        if (wr == 1) PG8_BAR;
    }
    PG8_WAIT_V(0);
    PG8_BAR;
#undef PG8_SA
#undef PG8_SB
#undef PG8_STAGE
#undef PG8_LDA
#undef PG8_LDB
#undef PG8_MMA
#undef PG8_WAIT_V
#undef PG8_WAIT_L
#undef PG8_BAR
#undef PG8_SCHED
}
}
using pg8::Unit;
typedef const f32x4 (&AccRef)[2][2][4][2];

struct EpiAda {
    float* mods; const float* bias;
    DEV void operator()(AccRef acc, const Unit& u, int wr, int wc, int fr, int fq) const {
        if (u.pm != 0 || wr != 0) return;
#pragma unroll
        for (int m = 0; m < 2; ++m) { const int r = 16 * m + fr;
#pragma unroll
            for (int bj = 0; bj < 2; ++bj)
#pragma unroll
                for (int n = 0; n < 2; ++n) { const int c = u.pn * 256 + bj * 128 + wc * 32 + n * 16 + 4 * fq;
                    const f32x4 bv = *(const f32x4*)(bias + c); *(f32x4*)(mods + (size_t)r * NMODS + c) = acc[0][bj][m][n] + bv; } }
    }
};
struct EpiSwiglu {
    bf16_t* G;
    DEV void operator()(AccRef acc, const Unit& u, int wr, int wc, int fr, int fq) const {
        const int hc = 128 * u.pn + 32 * wc + 8 * fq;
#pragma unroll
        for (int ai = 0; ai < 2; ++ai)
#pragma unroll
            for (int m = 0; m < 4; ++m) { const int r = u.pm * 256 + ai * 128 + wr * 64 + m * 16 + fr;
                const f32x4 a0 = acc[ai][0][m][0], a1 = acc[ai][0][m][1], b0 = acc[ai][1][m][0], b1 = acc[ai][1][m][1];
                u32x4 w; w.x = cvt_pk_bf16(siluf_(a0[0]) * b0[0], siluf_(a0[1]) * b0[1]); w.y = cvt_pk_bf16(siluf_(a0[2]) * b0[2], siluf_(a0[3]) * b0[3]);
                w.z = cvt_pk_bf16(siluf_(a1[0]) * b1[0], siluf_(a1[1]) * b1[1]); w.w = cvt_pk_bf16(siluf_(a1[2]) * b1[2], siluf_(a1[3]) * b1[3]);
                *(u32x4*)(G + (size_t)r * FF + hc) = w; }
    }
};
struct EpiResid {
    const float* xp; const float* xs; float* out; const float* gate; float scale; int from_input;
    DEV void operator()(AccRef acc, const Unit& u, int wr, int wc, int fr, int fq) const {
#pragma unroll
        for (int ai = 0; ai < 2; ++ai)
#pragma unroll
            for (int m = 0; m < 4; ++m) { const int r = u.pm * 256 + ai * 128 + wr * 64 + m * 16 + fr; const int bi = brow(r);
                const float* xin = from_input ? (r < MP ? xp + (size_t)r * DM : xs + (size_t)(r - MP) * DM) : out + (size_t)r * DM;
                float* xo = out + (size_t)r * DM; const float* gp = gate + (size_t)bi * NMODS;
#pragma unroll
                for (int bj = 0; bj < 2; ++bj)
#pragma unroll
                    for (int n = 0; n < 2; ++n) { const int c = u.pn * 256 + bj * 128 + wc * 32 + n * 16 + 4 * fq;
                        const f32x4 xv = *(const f32x4*)(xin + c), gv = *(const f32x4*)(gp + c);
                        *(f32x4*)(xo + c) = xv + (gv + 1.f) * scale * acc[ai][bj][m][n]; }
                asm volatile("" ::: "memory"); }
    }
};
struct EpiPartial {
    float* part;
    DEV void operator()(AccRef acc, const Unit& u, int wr, int wc, int fr, int fq) const {
#pragma unroll
        for (int ai = 0; ai < 2; ++ai)
#pragma unroll
            for (int m = 0; m < 4; ++m) { const int rl = (u.pm - 256) * 256 + ai * 128 + wr * 64 + m * 16 + fr; float* rowp = part + ((size_t)u.kc * 512 + rl) * DM;
#pragma unroll
                for (int bj = 0; bj < 2; ++bj)
#pragma unroll
                    for (int n = 0; n < 2; ++n) { const int c = u.pn * 256 + bj * 128 + wc * 32 + n * 16 + 4 * fq; *(f32x4*)(rowp + c) = acc[ai][bj][m][n]; } }
    }
};
struct EpiBf16 {
    bf16_t* O; int ldo;
    DEV void operator()(AccRef acc, const Unit& u, int wr, int wc, int fr, int fq) const {
#pragma unroll
        for (int ai = 0; ai < 2; ++ai)
#pragma unroll
            for (int m = 0; m < 4; ++m) { const int r = u.pm * 256 + ai * 128 + wr * 64 + m * 16 + fr; bf16_t* rowp = O + (size_t)r * ldo;
#pragma unroll
                for (int bj = 0; bj < 2; ++bj) { const int c = u.pn * 256 + bj * 128 + wc * 32 + 8 * fq; const f32x4 a = acc[ai][bj][m][0], b = acc[ai][bj][m][1];
                    u32x4 w; w.x = cvt_pk_bf16(a[0], a[1]); w.y = cvt_pk_bf16(a[2], a[3]); w.z = cvt_pk_bf16(b[0], b[1]); w.w = cvt_pk_bf16(b[2], b[3]); *(u32x4*)(rowp + c) = w; } }
    }
};
struct EpiLora {
    float* decay; bf16_t* abuf; bf16_t* gbuf; const float* w0; const float* a0;
    DEV void operator()(AccRef acc, const Unit& u, int wr, int wc, int fr, int fq) const {
        const int seg = u.pn >> 1; const int cb = (u.pn & 1) * 256 + wc * 32 + 8 * fq;
        const float* bias = seg == 0 ? w0 : a0; bf16_t* ob = seg == 1 ? abuf : gbuf;
#pragma unroll
        for (int ai = 0; ai < 2; ++ai)
#pragma unroll
            for (int m = 0; m < 4; ++m) { const int r = u.pm * 256 + ai * 128 + wr * 64 + m * 16 + fr;
#pragma unroll
                for (int bj = 0; bj < 2; ++bj) { const int c = cb + bj * 128; f32x4 a = acc[ai][bj][m][0], b = acc[ai][bj][m][1];
                    if (seg < 2) { a = a + *(const f32x4*)(bias + c); b = b + *(const f32x4*)(bias + c + 4); }
                    if (seg == 0) { *(f32x4*)(decay + (size_t)r * 512 + c) = a; *(f32x4*)(decay + (size_t)r * 512 + c + 4) = b; }
                    else { if (seg == 1) {
#pragma unroll
                            for (int e = 0; e < 4; ++e) { a[e] = sigmoidf_(a[e]); b[e] = sigmoidf_(b[e]); } }
                        u32x4 w; w.x = cvt_pk_bf16(a[0], a[1]); w.y = cvt_pk_bf16(a[2], a[3]); w.z = cvt_pk_bf16(b[0], b[1]); w.w = cvt_pk_bf16(b[2], b[3]); *(u32x4*)(ob + (size_t)r * 512 + c) = w; } }
                asm volatile("" ::: "memory"); }
    }
};
struct EpiGlu {
    const bf16_t* ya; bf16_t* yb;
    DEV void operator()(AccRef acc, const Unit& u, int wr, int wc, int fr, int fq) const {
#pragma unroll
        for (int ai = 0; ai < 2; ++ai)
#pragma unroll
            for (int m = 0; m < 4; ++m) { const int r = u.pm * 256 + ai * 128 + wr * 64 + m * 16 + fr;
#pragma unroll
                for (int bj = 0; bj < 2; ++bj) { const int c = u.pn * 256 + bj * 128 + wc * 32 + 8 * fq; const f32x4 a = acc[ai][bj][m][0], b = acc[ai][bj][m][1];
                    const u32x4 yv = *(const u32x4*)(ya + (size_t)r * 512 + c);
                    u32x4 w; w.x = cvt_pk_bf16(bflo(yv.x) * sigmoidf_(a[0]), bfhi(yv.x) * sigmoidf_(a[1])); w.y = cvt_pk_bf16(bflo(yv.y) * sigmoidf_(a[2]), bfhi(yv.y) * sigmoidf_(a[3]));
                    w.z = cvt_pk_bf16(bflo(yv.z) * sigmoidf_(b[0]), bfhi(yv.z) * sigmoidf_(b[1])); w.w = cvt_pk_bf16(bflo(yv.w) * sigmoidf_(b[2]), bfhi(yv.w) * sigmoidf_(b[3]));
                    *(u32x4*)(yb + (size_t)r * DM + c) = w; } }
    }
};

struct Job { const float* s0; const float* s1; int ld, K, Nd, mode; bf16_t* dst; };
DEV Job get_job(CP p, int j) {
    Job J; J.s1 = nullptr; J.mode = 0; bf16_t* W = (bf16_t*)(p.ws + OFF_W);
    if (j < 2) { J.s0 = p.in[9] + (size_t)j * 1024 * 9216; J.ld = 9216; J.K = 1024; J.Nd = 9216; J.dst = (bf16_t*)(p.ws + OFF_B + B_ADA) + (size_t)j * 9216 * 1024; }
    else if (j < 6) { const int q = j - 2, l = q >> 1, f = q & 1; J.s0 = p.in[f ? 17 : 14] + (size_t)l * 1024 * FF; J.s1 = p.in[f ? 18 : 15] + (size_t)l * 1024 * FF;
        J.ld = FF; J.K = 1024; J.Nd = 5632; J.mode = 1; J.dst = (bf16_t*)((unsigned char*)W + W_UP + q * SZ_UP); }
    else if (j < 10) { const int q = j - 6, l = q >> 1, f = q & 1; J.s0 = p.in[f ? 19 : 16] + (size_t)l * FF * 1024; J.ld = 1024; J.K = FF; J.Nd = 1024; J.dst = (bf16_t*)((unsigned char*)W + W_DN + q * SZ_DN); }
    else if (j == 10) { J.s0 = p.in[20]; J.ld = 2304; J.K = 1024; J.Nd = 2304; J.mode = 3; J.dst = (bf16_t*)((unsigned char*)W + W_ABIN); }
    else if (j == 11) { J.s0 = p.in[21]; J.ld = 1024; J.K = 1024; J.Nd = 1024; J.dst = (bf16_t*)((unsigned char*)W + W_ABOUT); }
    else if (j == 12) { J.s0 = p.in[30]; J.ld = 512; J.K = 512; J.Nd = 512; J.mode = 3; J.dst = (bf16_t*)((unsigned char*)W + W_GLU); }
    else if (j == 13) { J.s0 = p.in[33]; J.ld = 512; J.K = 256; J.Nd = 1536; J.mode = 2; J.dst = (bf16_t*)((unsigned char*)W + W_LORA); }
    else if (j == 14) { J.s0 = p.in[42]; J.ld = 4096; J.K = 1024; J.Nd = 4096; J.mode = 3; J.dst = (bf16_t*)((unsigned char*)W + W_CIN); }
    else { J.s0 = p.in[43]; J.ld = 1024; J.K = 1024; J.Nd = 1024; J.dst = (bf16_t*)((unsigned char*)W + W_COUT); }
    return J;
}
DEV void tr_load(CP p, const Job& J, int item, int lane, float (&v)[64]) {
    const int nblk = J.Nd / 64, kb = item / nblk, nb = item % nblk, k0 = 64 * kb, n0 = 64 * nb;
    const float* src = J.s0; int col = n0 + lane; bool valid = true; int krel0 = k0;
    const int rho = lane & 31, p32 = 8 * ((rho & 15) >> 2) + 4 * (rho >> 4) + (rho & 3);
    if (J.mode == 1) { const int n = n0 + lane, within = n & 255; col = 128 * (n >> 8) + 32 * ((within >> 5) & 3) + p32; src = (within >> 7) ? J.s1 : J.s0; }
    else if (J.mode == 3) { col = n0 + (lane & 32) + p32; }
    else if (J.mode == 2) { const int seg = n0 >> 9; col = ((n0 + (lane & 32)) & 511) + p32; src = seg == 0 ? p.in[33] : (seg == 1 ? p.in[35] : p.in[36]);
        valid = (seg == 0 && kb == 0) || (seg == 1 && kb == 1) || (seg == 2 && kb >= 2); krel0 = k0 - (seg == 0 ? 0 : (seg == 1 ? 64 : 128)); }
    const float* sp = src + (size_t)krel0 * J.ld + col;
#pragma unroll
    for (int i = 0; i < 64; ++i) v[i] = valid ? __builtin_nontemporal_load(sp + (size_t)i * J.ld) : 0.f;
}
DEV void tr_store(const Job& J, int item, LAS unsigned* scr, int lane, const float (&v)[64]) {
    const int nblk = J.Nd / 64, kb = item / nblk, nb = item % nblk, k0 = 64 * kb, n0 = 64 * nb;
#pragma unroll
    for (int i = 0; i < 32; ++i) scr[lane * 34 + i] = cvt_pk_bf16(v[2 * i], v[2 * i + 1]);
    asm volatile("s_waitcnt lgkmcnt(0)" ::: "memory");
#pragma unroll
    for (int j = 0; j < 8; ++j) { const int q = j * 64 + lane, n = q >> 3, c = q & 7;
        const u32x2 a = *(const LAS u32x2*)(scr + n * 34 + 4 * c), b = *(const LAS u32x2*)(scr + n * 34 + 4 * c + 2);
        *(u32x4*)(J.dst + (size_t)(n0 + n) * J.K + k0 + 8 * c) = (u32x4){a.x, a.y, b.x, b.y}; }
    asm volatile("s_waitcnt lgkmcnt(0)" ::: "memory");
}
DEV bool tr_decode(CP p, int idx, Job& J, int& item) {
    for (int j = 0; j < 16; ++j) { J = get_job(p, j); const int nit = (J.K / 64) * (J.Nd / 64); if (idx < nit) { item = idx; return true; } idx -= nit; }
    return false;
}
DEV void phase_prologue(CP p, LAS unsigned char* lds) {
    const int tid = tid_(), wave = tid >> 6, lane = tid & 63;
    LAS unsigned* scr = (LAS unsigned*)(lds + wave * 8704);
    const int gw = __builtin_amdgcn_readfirstlane(bid_() * 8 + wave), NW = gdim_() * 8;
    { int idx = gw; Job Jc; int ic = 0; bool vc = tr_decode(p, idx, Jc, ic); float v[64];
      if (vc) tr_load(p, Jc, ic, lane, v);
      while (vc) {
          idx += NW; Job Jn; int in_ = 0; const bool vn = tr_decode(p, idx, Jn, in_); float w[64];
          if (vn) tr_load(p, Jn, in_, lane, w);
          tr_store(Jc, ic, scr, lane, v);
          Jc = Jn; ic = in_; vc = vn;
#pragma unroll
          for (int i = 0; i < 64; ++i) v[i] = w[i];
      } }
    const int gt = bid_() * 512 + tid, NT = gdim_() * 512;
    bf16_t* acs = (bf16_t*)(p.ws + OFF_ACS);
    for (int i = gt; i < 256 * 1024; i += NT) { const int r = i >> 10, c = i & 1023; float v = 0.f;
        if (r < 16) v = siluf_(p.in[7][r * 1024 + c]); else if (r < 32) v = siluf_(p.in[8][(r - 16) * 1024 + c]);
        acs[i] = f2bf(v); }
    float* tab = (float*)(p.ws + OFF_TAB);
    for (int i = gt; i < 2048; i += NT) { const int g = i >> 6;
        const float dt = expf(p.in[24][g]), lr = p.in[22][i], li = p.in[23][i];
        const float mag = expf(lr * dt), th = li * dt, cs = cosf(th), sn = sinf(th), sh = sinf(0.5f * th);
        const float abr = mag * cs, abi = mag * sn;
        const float abr1 = expm1f(lr * dt) - 2.f * mag * sh * sh;
        const float den = lr * lr + li * li;
        const float zr = (abr1 * lr + abi * li) / den, zi = (abi * lr - abr1 * li) / den;
        tab[T_AB + 2 * i] = abr; tab[T_AB + 2 * i + 1] = abi;
#pragma unroll
        for (int h = 0; h < 16; ++h) { const float br = p.in[25][i * 16 + h], bi = p.in[26][i * 16 + h];
            tab[T_BBRE + i * 16 + h] = zr * br - zi * bi; tab[T_BBIM + i * 16 + h] = zr * bi + zi * br; } }
    for (int i = gt; i < 1024; i += NT) tab[T_LB + i] = 1.f / (1.f + expf(p.in[44][i] - p.in[44][1024 + i]));
}

DEV void phase_norm(CP p, int l, int which, int from_input, int fix, int fix_from_input, int fixn, float fixs) {
    const int tid = tid_(), wave = tid >> 6, lane = tid & 63, gw = bid_() * 8 + wave, NW = gdim_() * 8;
    const float* gamma = p.in[11 + which] + l * 1024;
    const float* mods = (const float*)(p.ws + OFF_MODS) + l * 9216 + 3 * which * 1024;
    bf16_t* H = (bf16_t*)(p.ws + OFF_H);
    f32x4 g4[4];
#pragma unroll
    for (int j = 0; j < 4; ++j) g4[j] = *(const f32x4*)(gamma + (lane + 64 * j) * 4);
    for (int r0 = gw * 2; r0 < MT; r0 += NW * 2) {
        f32x4 v[2][4];
#pragma unroll
        for (int u = 0; u < 2; ++u) { const int r = r0 + u;
            const bool fx = fix >= 0 && r >= MP;
            const float* xr = (from_input || (fx && fix_from_input)) ? (r < MP ? p.in[0] + (size_t)r * DM : p.in[1] + (size_t)(r - MP) * DM) : p.out + (size_t)r * DM;
#pragma unroll
            for (int j = 0; j < 4; ++j) v[u][j] = __builtin_nontemporal_load((const f32x4*)(xr + (lane + 64 * j) * 4));
            if (fx) { const float* part = (const float*)(p.ws + OFF_B + B_PART) + (size_t)(r - MP) * DM; const float* gp = (const float*)(p.ws + OFF_MODS) + (size_t)brow(r) * NMODS + fix;
#pragma unroll
                for (int j = 0; j < 4; ++j) { const int c = (lane + 64 * j) * 4; f32x4 sm = *(const f32x4*)(part + c);
                    for (int kc = 1; kc < fixn; ++kc) sm = sm + *(const f32x4*)(part + (size_t)kc * 512 * DM + c);
                    v[u][j] = v[u][j] + (*(const f32x4*)(gp + c) + 1.f) * fixs * sm; *(f32x4*)(p.out + (size_t)r * DM + c) = v[u][j]; } } }
#pragma unroll
        for (int u = 0; u < 2; ++u) { const int r = r0 + u; float ss = 0.f;
#pragma unroll
            for (int j = 0; j < 4; ++j) ss += (v[u][j][0] * v[u][j][0] + v[u][j][1] * v[u][j][1]) + (v[u][j][2] * v[u][j][2] + v[u][j][3] * v[u][j][3]);
            const float rstd = rsqrtf(wave_sum(ss) * (1.f / 1024.f) + 1e-6f);
            const float* mp = mods + (size_t)brow(r) * NMODS;
#pragma unroll
            for (int j = 0; j < 4; ++j) { const int c = (lane + 64 * j) * 4; const f32x4 sh = *(const f32x4*)(mp + c), sc = *(const f32x4*)(mp + 1024 + c);
                const f32x4 h = v[u][j] * rstd * g4[j] * (sc + 1.f) + sh;
                u32x2 w; w.x = cvt_pk_bf16(h[0], h[1]); w.y = cvt_pk_bf16(h[2], h[3]); *(u32x2*)(H + (size_t)r * DM + c) = w; } }
    }
}
DEV void phase_final_norm(CP p, int fix) {
    const int tid = tid_(), wave = tid >> 6, lane = tid & 63, gw = bid_() * 8 + wave, NW = gdim_() * 8;
    const float* gamma = p.in[46];
    f32x4 g4[4];
#pragma unroll
    for (int j = 0; j < 4; ++j) g4[j] = *(const f32x4*)(gamma + (lane + 64 * j) * 4);
    for (int r0 = gw * 2; r0 < MT; r0 += NW * 2) {
        f32x4 v[2][4];
#pragma unroll
        for (int u = 0; u < 2; ++u) { const int r = r0 + u; const float* xr = p.out + (size_t)r * DM;
#pragma unroll
            for (int j = 0; j < 4; ++j) v[u][j] = *(const f32x4*)(xr + (lane + 64 * j) * 4);
            if (r >= MP) { const float* part = (const float*)(p.ws + OFF_B + B_PART) + (size_t)(r - MP) * DM; const float* gp = (const float*)(p.ws + OFF_MODS) + (size_t)brow(r) * NMODS + fix;
#pragma unroll
                for (int j = 0; j < 4; ++j) { const int c = (lane + 64 * j) * 4; f32x4 sm = *(const f32x4*)(part + c);
                    for (int kc = 1; kc < 11; ++kc) sm = sm + *(const f32x4*)(part + (size_t)kc * 512 * DM + c);
                    v[u][j] = v[u][j] + (*(const f32x4*)(gp + c) + 1.f) * 0.5f * sm; } } }
#pragma unroll
        for (int u = 0; u < 2; ++u) { float* xr = p.out + (size_t)(r0 + u) * DM; float ss = 0.f;
#pragma unroll
            for (int j = 0; j < 4; ++j) ss += (v[u][j][0] * v[u][j][0] + v[u][j][1] * v[u][j][1]) + (v[u][j][2] * v[u][j][2] + v[u][j][3] * v[u][j][3]);
            const float rstd = rsqrtf(wave_sum(ss) * (1.f / 1024.f) + 1e-6f);
#pragma unroll
            for (int j = 0; j < 4; ++j) __builtin_nontemporal_store(v[u][j] * rstd * g4[j], (f32x4*)(xr + (lane + 64 * j) * 4)); }
    }
}

DEV void phase_even_prep(CP p) {
    const int tid = tid_(), wave = tid >> 6, lane = tid & 63, gw = bid_() * 8 + wave, NW = gdim_() * 8;
    const bf16_t* P = (const bf16_t*)(p.ws + OFF_B + B_P);
    bf16_t* LA = (bf16_t*)(p.ws + OFF_B + B_LORA);
    const int j4 = lane * 4, cidx = 1536 + j4;
    const f32x4 mu = *(const f32x4*)(p.in[31] + cidx);
    #pragma unroll 1
    for (int r0 = gw * 2; r0 < MT; r0 += NW * 2) {
        u32x2 cu[2], pu[2]; f32x4 sp[2];
#pragma unroll
        for (int u = 0; u < 2; ++u) { const int r = r0 + u; const bool smp = r >= MP; const int t = smp ? ((r - MP) & 31) : (r & 4095);
            cu[u] = *(const u32x2*)(P + (size_t)r * LDP_E + 512 + cidx);
            if (t > 0) pu[u] = *(const u32x2*)(P + (size_t)(r - 1) * LDP_E + 512 + cidx);
            else if (smp) sp[u] = *(const f32x4*)(p.in[5] + ((r - MP) >> 5) * 1792 + cidx); }
#pragma unroll
        for (int u = 0; u < 2; ++u) { const int r = r0 + u; const bool smp = r >= MP; const int t = smp ? ((r - MP) & 31) : (r & 4095);
            const f32x4 cur = (f32x4){bflo(cu[u].x), bfhi(cu[u].x), bflo(cu[u].y), bfhi(cu[u].y)};
            f32x4 prev;
            if (t > 0) prev = (f32x4){bflo(pu[u].x), bfhi(pu[u].x), bflo(pu[u].y), bfhi(pu[u].y)}; else if (smp) prev = sp[u]; else prev = (f32x4){0.f, 0.f, 0.f, 0.f};
            const f32x4 ps = cur + (prev - cur) * mu; f32x4 o;
#pragma unroll
            for (int e = 0; e < 4; ++e) { const float x = ps[e]; o[e] = lane < 16 ? (1.f - 2.f / (1.f + __expf(2.f * x))) : (lane < 32 ? x : sigmoidf_(x)); }
            u32x2 w; w.x = cvt_pk_bf16(o[0], o[1]); w.y = cvt_pk_bf16(o[2], o[3]);
            *(u32x2*)(LA + (size_t)r * 256 + j4) = w; }
    }
    const int gt = bid_() * 512 + tid, NT = gdim_() * 512;
    for (int i = gt; i < 2 * 16 * 1792; i += NT) { const int s = i / (16 * 1792), rem = i % (16 * 1792), b = rem / 1792, c = rem % 1792;
        const int row = s ? MP + b * 32 + 31 : b * 4096 + 4095;
        p.out[(s ? O_SHIFT_S : O_SHIFT_P) + (size_t)b * 1792 + c] = bf2f(P[(size_t)row * LDP_E + 512 + c]); }
}

template <bool STORE>
DEV void s5_pass(CP p, LAS unsigned char* lds) {
    const int tid = tid_(), wave = tid >> 6, lane = tid & 63, li = lane & 15, lq = lane >> 4;
    const int G32 = gdim_() >> 5; if ((int)bid_() >= G32 * 32) return;
    const int xcd_ = bid_() & 7, idx_ = bid_() >> 3, g = 4 * xcd_ + (idx_ & 3), slot = idx_ >> 2, ws0 = slot * 8 + wave, nws = G32 * 8;
    const float* tab = (const float*)(p.ws + OFF_TAB);
    const bf16_t* P = (const bf16_t*)(p.ws + OFF_B + B_P);
    float* E = (float*)(p.ws + OFF_S5E); float* ES = (float*)(p.ws + OFF_S5ES);
    bf16_t* YA = (bf16_t*)(p.ws + OFF_B + B_YA);
    float a1r[4], a1i[4], alr[4], ali[4], a16r[4], a16i[4];
#pragma unroll
    for (int pc = 0; pc < 4; ++pc) { const float ar = tab[T_AB + 2 * (g * 64 + 16 * pc + li)], ai = tab[T_AB + 2 * (g * 64 + 16 * pc + li) + 1];
        const float r2 = ar * ar - ai * ai, i2 = 2.f * ar * ai, r4 = r2 * r2 - i2 * i2, i4 = 2.f * r2 * i2, r8 = r4 * r4 - i4 * i4, i8 = 2.f * r4 * i4;
        const float r12 = r8 * r4 - i8 * i4, i12 = r8 * i4 + i8 * r4;
        a1r[pc] = ar; a1i[pc] = ai; a16r[pc] = r8 * r8 - i8 * i8; a16i[pc] = 2.f * r8 * i8;
        alr[pc] = lq == 0 ? 1.f : (lq == 1 ? r4 : (lq == 2 ? r8 : r12)); ali[pc] = lq == 0 ? 0.f : (lq == 1 ? i4 : (lq == 2 ? i8 : i12)); }
    bf16x8 bfrag[8];
#pragma unroll
    for (int cb = 0; cb < 8; ++cb) { u32x4 w = (u32x4){0u, 0u, 0u, 0u};
        if (lq < 2) { const float* src = tab + ((cb >> 2) ? T_BBIM : T_BBRE) + (g * 64 + 16 * (cb & 3) + li) * 16 + 8 * lq; const f32x4 c0 = *(const f32x4*)src, c1 = *(const f32x4*)(src + 4);
            w.x = cvt_pk_bf16(c0[0], c0[1]); w.y = cvt_pk_bf16(c0[2], c0[3]); w.z = cvt_pk_bf16(c1[0], c1[1]); w.w = cvt_pk_bf16(c1[2], c1[3]); }
        bfrag[cb] = __builtin_bit_cast(bf16x8, w); }
    const int h = li, kq = lq;
    bf16x8 bfr[4]; float dsk = 0.f;
    if (STORE) {
        dsk = p.in[29][g * 16 + h];
#pragma unroll
        for (int kk = 0; kk < 4; ++kk) { const int k = kk * 32 + kq * 8; const bool im = k >= 64; const float* src = (im ? p.in[28] : p.in[27]) + (size_t)(g * 16 + h) * 64 + (k & 63);
            const f32x4 c0 = *(const f32x4*)src, c1 = *(const f32x4*)(src + 4); const float sg = im ? -1.f : 1.f;
            u32x4 w; w.x = cvt_pk_bf16(sg * c0[0], sg * c0[1]); w.y = cvt_pk_bf16(sg * c0[2], sg * c0[3]); w.z = cvt_pk_bf16(sg * c1[0], sg * c1[1]); w.w = cvt_pk_bf16(sg * c1[2], sg * c1[3]);
            bfr[kk] = __builtin_bit_cast(bf16x8, w); }
    }
    LAS bf16_t* xs = (LAS bf16_t*)(lds + wave * 4352);
    u32x4 nafr[4];
#define S5_FETCH(rs) do { const int rs_ = (rs); \
        _Pragma("unroll") for (int q = 0; q < 4; ++q) nafr[q] = (u32x4){0u, 0u, 0u, 0u}; \
        if (rs_ < 1024 + 16) { int row0_, T_; \
            if (rs_ < 1024) { const int b_ = rs_ >> 6, c_ = rs_ & 63; row0_ = b_ * 4096 + c_ * 64; T_ = 64; } \
            else { const int b_ = rs_ - 1024; row0_ = MP + b_ * 32; T_ = 32; } \
            if (lq < 2) { _Pragma("unroll") for (int q = 0; q < 4; ++q) if (16 * q < T_) nafr[q] = *(const u32x4*)(P + (size_t)(row0_ + 16 * q + li) * LDP_E + g * 16 + 8 * lq); } } } while (0)
    S5_FETCH(ws0);
    for (int rest = ws0; rest < 1024 + 16; rest += nws) {
        int row0, T; size_t eidx;
        if (rest < 1024) { const int b = rest >> 6, c = rest & 63; row0 = b * 4096 + c * 64; T = 64; eidx = ((size_t)(b * 32 + g) * 64 + c) * 128; }
        else { const int b = rest - 1024; row0 = MP + b * 32; T = 32; eidx = (size_t)(b * 32 + g) * 128; }
        float hr[4], hi[4]; u32x4 afr[4];
#pragma unroll
        for (int q = 0; q < 4; ++q) { afr[q] = nafr[q]; hr[q] = 0.f; hi[q] = 0.f;
            if (STORE) { if (rest < 1024) { hr[q] = E[eidx + 16 * q + li]; hi[q] = E[eidx + 64 + 16 * q + li]; } else { hr[q] = p.in[2][(rest - 1024) * 2048 + g * 64 + 16 * q + li]; hi[q] = p.in[3][(rest - 1024) * 2048 + g * 64 + 16 * q + li]; } } }
        S5_FETCH(rest + nws);
#pragma unroll 1
        for (int blk = 0; blk < T / 16; ++blk) { {
            const bf16x8 acur = __builtin_bit_cast(bf16x8, afr[0]); afr[0] = afr[1]; afr[1] = afr[2]; afr[2] = afr[3];
            f32x4 D[8];
#pragma unroll
            for (int cb = 0; cb < 8; ++cb) D[cb] = __builtin_amdgcn_mfma_f32_16x16x32_bf16(acur, bfrag[cb], (f32x4){0.f, 0.f, 0.f, 0.f}, 0, 0, 0);
#pragma unroll
            for (int pc = 0; pc < 4; ++pc) {
                float xr[4], xi[4];
                xr[0] = D[pc][0]; xi[0] = D[pc + 4][0];
#pragma unroll
                for (int r = 1; r < 4; ++r) { xr[r] = a1r[pc] * xr[r - 1] - a1i[pc] * xi[r - 1] + D[pc][r]; xi[r] = a1r[pc] * xi[r - 1] + a1i[pc] * xr[r - 1] + D[pc + 4][r]; }
                float er = xr[3], ei = xi[3];
                const float q2r = a1r[pc] * a1r[pc] - a1i[pc] * a1i[pc], q2i = 2.f * a1r[pc] * a1i[pc], q4r = q2r * q2r - q2i * q2i, q4i = 2.f * q2r * q2i, q8r = q4r * q4r - q4i * q4i, q8i = 2.f * q4r * q4i;
                { const float tr = __shfl_up(er, 16), ti = __shfl_up(ei, 16); if (lq >= 1) { er += q4r * tr - q4i * ti; ei += q4r * ti + q4i * tr; } }
                { const float tr = __shfl_up(er, 32), ti = __shfl_up(ei, 32); if (lq >= 2) { er += q8r * tr - q8i * ti; ei += q8r * ti + q8i * tr; } }
                float cr = __shfl_up(er, 16), ci = __shfl_up(ei, 16); if (lq == 0) { cr = 0.f; ci = 0.f; }
                const float nr = __shfl(er, 48 + li), ni = __shfl(ei, 48 + li);
                cr += alr[pc] * hr[pc] - ali[pc] * hi[pc]; ci += alr[pc] * hi[pc] + ali[pc] * hr[pc];
                const float h2r = nr + a16r[pc] * hr[pc] - a16i[pc] * hi[pc], h2i = ni + a16r[pc] * hi[pc] + a16i[pc] * hr[pc];
                hr[pc] = h2r; hi[pc] = h2i;
                if (STORE) {
#pragma unroll
                    for (int r = 0; r < 4; ++r) { const float yr = a1r[pc] * cr - a1i[pc] * ci, yi = a1r[pc] * ci + a1i[pc] * cr; cr = yr; ci = yi;
                        xs[(4 * lq + r) * 136 + 16 * pc + li] = f2bf(xr[r] + yr); xs[(4 * lq + r) * 136 + 64 + 16 * pc + li] = f2bf(xi[r] + yi); } }
            }
            if (STORE) {
                asm volatile("s_waitcnt lgkmcnt(0)" ::: "memory");
                f32x4 acc = (f32x4){0.f, 0.f, 0.f, 0.f};
#pragma unroll
                for (int kk = 0; kk < 4; ++kk) { const bf16x8 a = *(const LAS bf16x8*)(xs + h * 136 + kk * 32 + kq * 8); acc = __builtin_amdgcn_mfma_f32_16x16x32_bf16(a, bfr[kk], acc, 0, 0, 0); }
                asm volatile("s_waitcnt lgkmcnt(0)" ::: "memory");
#pragma unroll
                for (int r = 0; r < 4; ++r) { const int tt = blk * 16 + 4 * kq + r; const size_t row = (size_t)(row0 + tt);
                    const float uval = bf2f(P[row * LDP_E + g * 16 + h]); const float y = acc[r] + uval * dsk;
                    const float tz = 0.7978845608f * (y + 0.044715f * y * y * y); const float th = 1.f - 2.f * __builtin_amdgcn_rcpf(1.f + __builtin_amdgcn_exp2f(2.88539008f * tz)); const float ge = 0.5f * y * (1.f + th);
                    YA[row * 512 + g * 16 + h] = f2bf(ge); }
            }
        } }
        if (!STORE && lq == 0) {
#pragma unroll
            for (int q = 0; q < 4; ++q) { if (rest < 1024) { E[eidx + 16 * q + li] = hr[q]; E[eidx + 64 + 16 * q + li] = hi[q]; } else { ES[eidx + 16 * q + li] = hr[q]; ES[eidx + 64 + 16 * q + li] = hi[q]; } } }
    }
#undef S5_FETCH
}
DEV void s5_pass2(CP p) {
    const int gt = bid_() * 512 + tid_(), NT = gdim_() * 512;
    const float* tab = (const float*)(p.ws + OFF_TAB);
    float* E = (float*)(p.ws + OFF_S5E); const float* ES = (const float*)(p.ws + OFF_S5ES);
    for (int i = gt; i < 65536; i += NT) { const int smp = i >> 15, j = i & 32767, bg = j >> 6, pp = j & 63, g = bg & 31;
        float ar = tab[T_AB + 2 * (g * 64 + pp)], ai = tab[T_AB + 2 * (g * 64 + pp) + 1];
        const int nsq = smp ? 5 : 6;
        for (int s = 0; s < nsq; ++s) { const float nr = ar * ar - ai * ai, ni = 2.f * ar * ai; ar = nr; ai = ni; }
        if (!smp) { float cr = 0.f, ci = 0.f;
            for (int c = 0; c < 64; ++c) { const size_t e = ((size_t)bg * 64 + c) * 128; const float er = E[e + pp], ei = E[e + 64 + pp];
                E[e + pp] = cr; E[e + 64 + pp] = ci; const float nr = ar * cr - ai * ci + er, ni = ar * ci + ai * cr + ei; cr = nr; ci = ni; }
            p.out[O_S5RE_P + j] = cr; p.out[O_S5IM_P + j] = ci; }
        else { const float hr = p.in[2][j], hi = p.in[3][j]; const float er = ES[(size_t)bg * 128 + pp], ei = ES[(size_t)bg * 128 + 64 + pp];
            p.out[O_S5RE_S + j] = ar * hr - ai * hi + er; p.out[O_S5IM_S + j] = ar * hi + ai * hr + ei; } }
}

typedef float f32x2 __attribute__((ext_vector_type(2)));
#define LO2(v) __builtin_shufflevector(v, v, 0, 1)
#define HI2(v) __builtin_shufflevector(v, v, 2, 3)
DEV void rwkv_scan(CP p, LAS unsigned char* lds) {
    const int tid = tid_();
    const bf16_t* P = (const bf16_t*)(p.ws + OFF_B + B_P);
    const float* DEC = (const float*)(p.ws + OFF_B + B_DECAY); const bf16_t* AB = (const bf16_t*)(p.ws + OFF_B + B_ABUF);
    float* YR = (float*)(p.ws + OFF_B + B_YRAW);
    LAS float* bufs = (LAS float*)lds;
    const int rloc = tid >> 4, kq = tid & 15, ch = tid & 63, tsub = tid >> 6;
    for (int item = bid_(); item < 512; item += gdim_()) {
        const int smp = item >> 8, it = item & 255, b = it >> 4, h = (it >> 1) & 7, half = it & 1;
        const int L = smp ? 32 : 4096, row0 = smp ? MP + b * 32 : b * 4096, nch = L / 32;
        const int row = half * 32 + rloc, cidx = h * 64 + ch;
        f32x2 S01, S23;
        if (smp) { const f32x4 s = *(const f32x4*)(p.in[4] + ((size_t)(b * 8 + h) * 64 + row) * 64 + 4 * kq); S01 = LO2(s); S23 = HI2(s); }
        else { S01 = (f32x2){0.f, 0.f}; S23 = S01; }
        const float mu_r = p.in[31][cidx], mu_k = p.in[31][512 + cidx], mu_v = p.in[31][1024 + cidx], kkc = p.in[37][cidx], kac = p.in[38][cidx];
        float sp0 = 0.f, sp1 = 0.f, sp2 = 0.f;
        if (smp) { const float* sp = p.in[5] + b * 1792 + cidx; sp0 = sp[0]; sp1 = sp[512]; sp2 = sp[1024]; }
        bf16_t rh[4][7]; float rd[4];
        __syncthreads();
#define RW_LOAD(c) do { _Pragma("unroll") for (int i = 0; i < 4; ++i) { const int t = (c) * 32 + i * 8 + tsub; const size_t gr = (size_t)(row0 + t); \
            const bf16_t* pc = P + gr * LDP_E + 512 + cidx; const bf16_t* pp = pc - (t > 0 ? LDP_E : 0); \
            rh[i][0] = pc[0]; rh[i][1] = pc[512]; rh[i][2] = pc[1024]; rh[i][3] = pp[0]; rh[i][4] = pp[512]; rh[i][5] = pp[1024]; \
            rh[i][6] = AB[gr * 512 + cidx]; rd[i] = DEC[gr * 512 + cidx]; } } while (0)
#define RW_PROC(buf, c) do { _Pragma("unroll") for (int i = 0; i < 4; ++i) { const int tl = i * 8 + tsub; const bool first = ((c) * 32 + tl) == 0; \
            const float cr_ = bf2f(rh[i][0]), ck_ = bf2f(rh[i][1]), cv_ = bf2f(rh[i][2]); \
            const float pr_ = first ? sp0 : bf2f(rh[i][3]), pk_ = first ? sp1 : bf2f(rh[i][4]), pv_ = first ? sp2 : bf2f(rh[i][5]); \
            const float r = cr_ + (pr_ - cr_) * mu_r, k = ck_ + (pk_ - ck_) * mu_k, v = cv_ + (pv_ - cv_) * mu_v, a = bf2f(rh[i][6]); \
            float kk = k * kkc; float n2 = red16(kk * kk); n2 += __shfl_xor(n2, 16); n2 += __shfl_xor(n2, 32); kk = kk * __builtin_amdgcn_rsqf(fmaxf(n2, 1e-24f)); \
            LAS float* bp = (buf) + tl * 64 + ch; bp[0] = r; bp[2048] = k * (1.f + (a - 1.f) * kac); bp[4096] = v; \
            { const float z = -rd[i]; const float sp = fmaxf(z, 0.f) + 0.69314718f * __builtin_amdgcn_logf(1.f + __builtin_amdgcn_exp2f(-1.44269504f * fabsf(z))); bp[6144] = __builtin_amdgcn_exp2f(-1.44269504f * __builtin_amdgcn_exp2f(-1.44269504f * (sp + 0.5f))); } \
            bp[8192] = -kk; bp[10240] = kk * a; } } while (0)
        RW_LOAD(0); RW_PROC(bufs, 0);
        __syncthreads();
        for (int c = 0; c < nch; ++c) {
            const LAS float* cb = bufs + (c & 1) * 12288 + 4 * kq;
            const LAS float* vb = bufs + (c & 1) * 12288 + 4096 + row;
            if (c + 1 < nch) RW_LOAD(c + 1);
            f32x4 r4 = *(const LAS f32x4*)(cb), k4 = *(const LAS f32x4*)(cb + 2048), w4 = *(const LAS f32x4*)(cb + 6144), a4 = *(const LAS f32x4*)(cb + 8192), b4 = *(const LAS f32x4*)(cb + 10240);
            float vv = vb[0];
#pragma unroll
            for (int tb = 0; tb < 2; ++tb) {
                float yp[16];
#pragma unroll
                for (int t16 = 0; t16 < 16; ++t16) {
                    const int tn = (tb * 16 + t16 + 1) & 31;
                    const f32x4 nr4 = *(const LAS f32x4*)(cb + tn * 64), nk4 = *(const LAS f32x4*)(cb + 2048 + tn * 64), nw4 = *(const LAS f32x4*)(cb + 6144 + tn * 64),
                                na4 = *(const LAS f32x4*)(cb + 8192 + tn * 64), nb4 = *(const LAS f32x4*)(cb + 10240 + tn * 64);
                    const float nvv = vb[tn * 64];
                    const f32x2 t2 = S01 * LO2(a4) + S23 * HI2(a4);
                    const f32x2 vv2 = (f32x2){vv, vv};
                    const f32x2 u01 = S01 * LO2(w4) + vv2 * LO2(k4), u23 = S23 * HI2(w4) + vv2 * HI2(k4);
                    const float sa = red16(t2.x + t2.y);
                    const f32x2 sa2 = (f32x2){sa, sa};
                    S01 = sa2 * LO2(b4) + u01; S23 = sa2 * HI2(b4) + u23;
                    const f32x2 y2 = S01 * LO2(r4) + S23 * HI2(r4);
                    yp[t16] = y2.x + y2.y;
                    r4 = nr4; k4 = nk4; w4 = nw4; a4 = na4; b4 = nb4; vv = nvv;
                }
                float yq[8], yr[4];
#pragma unroll
                for (int i = 0; i < 8; ++i) { const float keep = (kq & 1) ? yp[2 * i + 1] : yp[2 * i], send = (kq & 1) ? yp[2 * i] : yp[2 * i + 1]; yq[i] = keep + dppf<0xB1>(send); }
#pragma unroll
                for (int i = 0; i < 4; ++i) { const float keep = (kq & 2) ? yq[2 * i + 1] : yq[2 * i], send = (kq & 2) ? yq[2 * i] : yq[2 * i + 1]; yr[i] = keep + dppf<0x4E>(send); }
#pragma unroll
                for (int i = 0; i < 4; ++i) { yr[i] += dppf<0x124>(yr[i]); yr[i] += dppf<0x128>(yr[i]); }
                const float ysel = (kq >> 2) == 0 ? yr[0] : ((kq >> 2) == 1 ? yr[1] : ((kq >> 2) == 2 ? yr[2] : yr[3]));
                YR[(size_t)(row0 + c * 32 + tb * 16 + kq) * 512 + h * 64 + row] = ysel;
            }
            if (c + 1 < nch) RW_PROC(bufs + ((c + 1) & 1) * 12288, c + 1);
            __syncthreads();
        }
#undef RW_LOAD
#undef RW_PROC
        float* so = p.out + (smp ? O_RWKV_S : O_RWKV_P) + ((size_t)(b * 8 + h) * 64 + row) * 64 + 4 * kq;
        *(f32x4*)so = (f32x4){S01.x, S01.y, S23.x, S23.y};
    }
}
DEV void rwkv_post(CP p) {
    const int tid = tid_(), wave = tid >> 6, lane = tid & 63, gw = bid_() * 8 + wave, NW = gdim_() * 8;
    const bf16_t* P = (const bf16_t*)(p.ws + OFF_B + B_P);
    const bf16_t* AB = (const bf16_t*)(p.ws + OFF_B + B_ABUF); const bf16_t* GB = (const bf16_t*)(p.ws + OFF_B + B_GBUF);
    const float* YR = (const float*)(p.ws + OFF_B + B_YRAW);
    bf16_t* YB = (bf16_t*)(p.ws + OFF_H);
    const int hq = lane >> 4, j4 = (lane & 15) * 4;
    f32x4 mur[2], muk[2], muv[2], kac[2], rkc[2], lg[2], lb[2];
#pragma unroll
    for (int ps = 0; ps < 2; ++ps) { const int c = (hq + 4 * ps) * 64 + j4;
        mur[ps] = *(const f32x4*)(p.in[31] + c); muk[ps] = *(const f32x4*)(p.in[31] + 512 + c); muv[ps] = *(const f32x4*)(p.in[31] + 1024 + c);
        kac[ps] = *(const f32x4*)(p.in[38] + c); rkc[ps] = *(const f32x4*)(p.in[39] + c); lg[ps] = *(const f32x4*)(p.in[40] + c); lb[ps] = *(const f32x4*)(p.in[41] + c); }
    for (int r = gw; r < MT; r += NW) {
        const bool smp = r >= MP; const int t = smp ? ((r - MP) & 31) : (r & 4095);
        u32x2 cr[2], ck[2], cv[2], qr[2], qk[2], qv[2], av[2], gv[2]; f32x4 yv[2], sr[2], sk[2], sv[2];
#pragma unroll
        for (int ps = 0; ps < 2; ++ps) { const int c = (hq + 4 * ps) * 64 + j4; const bf16_t* pc = P + (size_t)r * LDP_E + 512 + c;
            cr[ps] = *(const u32x2*)pc; ck[ps] = *(const u32x2*)(pc + 512); cv[ps] = *(const u32x2*)(pc + 1024);
            if (t > 0) { const bf16_t* pp = pc - LDP_E; qr[ps] = *(const u32x2*)pp; qk[ps] = *(const u32x2*)(pp + 512); qv[ps] = *(const u32x2*)(pp + 1024); }
            else if (smp) { const float* sp = p.in[5] + ((r - MP) >> 5) * 1792 + c; sr[ps] = *(const f32x4*)sp; sk[ps] = *(const f32x4*)(sp + 512); sv[ps] = *(const f32x4*)(sp + 1024); }
            av[ps] = *(const u32x2*)(AB + (size_t)r * 512 + c); gv[ps] = *(const u32x2*)(GB + (size_t)r * 512 + c); yv[ps] = *(const f32x4*)(YR + (size_t)r * 512 + c); }
#pragma unroll
        for (int ps = 0; ps < 2; ++ps) { const int c = (hq + 4 * ps) * 64 + j4;
            const f32x4 fr = (f32x4){bflo(cr[ps].x), bfhi(cr[ps].x), bflo(cr[ps].y), bfhi(cr[ps].y)}, fk = (f32x4){bflo(ck[ps].x), bfhi(ck[ps].x), bflo(ck[ps].y), bfhi(ck[ps].y)},
                        fv = (f32x4){bflo(cv[ps].x), bfhi(cv[ps].x), bflo(cv[ps].y), bfhi(cv[ps].y)};
            f32x4 pr, pk, pv;
            if (t > 0) { pr = (f32x4){bflo(qr[ps].x), bfhi(qr[ps].x), bflo(qr[ps].y), bfhi(qr[ps].y)}; pk = (f32x4){bflo(qk[ps].x), bfhi(qk[ps].x), bflo(qk[ps].y), bfhi(qk[ps].y)};
                         pv = (f32x4){bflo(qv[ps].x), bfhi(qv[ps].x), bflo(qv[ps].y), bfhi(qv[ps].y)}; }
            else if (smp) { pr = sr[ps]; pk = sk[ps]; pv = sv[ps]; }
            else { pr = (f32x4){0.f, 0.f, 0.f, 0.f}; pk = pr; pv = pr; }
            const f32x4 rr = fr + (pr - fr) * mur[ps], k0 = fk + (pk - fk) * muk[ps], vv = fv + (pv - fv) * muv[ps];
            const f32x4 a = (f32x4){bflo(av[ps].x), bfhi(av[ps].x), bflo(av[ps].y), bfhi(av[ps].y)}, g = (f32x4){bflo(gv[ps].x), bfhi(gv[ps].x), bflo(gv[ps].y), bfhi(gv[ps].y)};
            const f32x4 km = k0 * ((a - 1.f) * kac[ps] + 1.f);
            const f32x4 y = yv[ps];
            const float mean = red16((y[0] + y[1]) + (y[2] + y[3])) * (1.f / 64.f);
            const f32x4 d = y - mean;
            const float var = red16((d[0] * d[0] + d[1] * d[1]) + (d[2] * d[2] + d[3] * d[3])) * (1.f / 64.f);
            const f32x4 bb = rr * km * rkc[ps];
            const float bonus = red16((bb[0] + bb[1]) + (bb[2] + bb[3]));
            const f32x4 o = (d * rsqrtf(var + 64e-5f) * lg[ps] + lb[ps] + vv * bonus) * g;
            u32x2 w; w.x = cvt_pk_bf16(o[0], o[1]); w.y = cvt_pk_bf16(o[2], o[3]);
            *(u32x2*)(YB + (size_t)r * DM + 512 + c) = w; }
    }
}

DEV void hgrn_scan(CP p, LAS unsigned char* lds) {
    const int tid = tid_();
    const bf16_t* P = (const bf16_t*)(p.ws + OFF_B);
    float* OR = (float*)(p.ws + OFF_B + B_ORAW);
    const float* lbt = (const float*)(p.ws + OFF_TAB) + T_LB;
    LAS float* bufs = (LAS float*)lds;
    const int cp = tid >> 4, kq = tid & 15, ch = tid & 127, tsub = tid >> 7, tv = tid >> 4, cv = (tid & 15) * 4;
    for (int item = bid_(); item < 512; item += gdim_()) {
        const int smp = item >> 8, it = item & 255, b = it >> 4, h = (it >> 1) & 7, half = it & 1;
        const int L = smp ? 32 : 4096, row0 = smp ? MP + b * 32 : b * 4096, nch = L / 32;
        const int col = half * 64 + 2 * cp;
        f32x2 S[8];
#pragma unroll
        for (int j = 0; j < 8; ++j) S[j] = smp ? *(const f32x2*)(p.in[6] + ((size_t)(b * 8 + h) * 128 + 8 * kq + j) * 128 + col) : (f32x2){0.f, 0.f};
        const float lb = lbt[h * 128 + ch], oml = 1.f - lb;
        bf16_t rq[8], rf[8]; u32x2 rv;
        __syncthreads();
#define HG_LOAD(c) do { _Pragma("unroll") for (int i = 0; i < 8; ++i) { const int t = (c) * 32 + i * 4 + tsub; const bf16_t* pc = P + (size_t)(row0 + t) * LDP_O + h * 128 + ch; \
            rq[i] = pc[0]; rf[i] = pc[1024]; } \
            rv = *(const u32x2*)(P + (size_t)(row0 + (c) * 32 + tv) * LDP_O + 2048 + h * 128 + half * 64 + cv); } while (0)
#define HG_PROC(buf) do { _Pragma("unroll") for (int i = 0; i < 8; ++i) { const int tl = i * 4 + tsub; (buf)[tl * 128 + ch] = siluf_(bf2f(rq[i])); (buf)[4096 + tl * 128 + ch] = oml * sigmoidf_(-bf2f(rf[i])); } \
            *(LAS f32x4*)((buf) + 8192 + tv * 64 + cv) = (f32x4){bflo(rv.x), bfhi(rv.x), bflo(rv.y), bfhi(rv.y)}; } while (0)
        HG_LOAD(0); HG_PROC(bufs);
        __syncthreads();
        for (int c = 0; c < nch; ++c) {
            const LAS float* qb = bufs + (c & 1) * 10240 + 8 * kq;
            const LAS float* vb = bufs + (c & 1) * 10240 + 8192 + 2 * cp;
            if (c + 1 < nch) HG_LOAD(c + 1);
            f32x4 q0 = *(const LAS f32x4*)(qb), q1 = *(const LAS f32x4*)(qb + 4), k0 = *(const LAS f32x4*)(qb + 4096), k1 = *(const LAS f32x4*)(qb + 4100);
            f32x2 v2 = *(const LAS f32x2*)(vb);
#pragma unroll 1
            for (int tb = 0; tb < 2; ++tb) {
                f32x2 osel = (f32x2){0.f, 0.f};
#pragma unroll
                for (int t16 = 0; t16 < 16; ++t16) {
                    const int tn = (tb * 16 + t16 + 1) & 31;
                    const f32x4 nq0 = *(const LAS f32x4*)(qb + tn * 128), nq1 = *(const LAS f32x4*)(qb + tn * 128 + 4), nk0 = *(const LAS f32x4*)(qb + 4096 + tn * 128), nk1 = *(const LAS f32x4*)(qb + 4100 + tn * 128);
                    const f32x2 nv2 = *(const LAS f32x2*)(vb + tn * 64);
                    f32x2 oa = (f32x2){0.f, 0.f}, ob = oa;
#pragma unroll
                    for (int e = 0; e < 4; ++e) {
                        S[e] = S[e] + (v2 - S[e]) * k0[e]; oa = oa + S[e] * q0[e];
                        S[4 + e] = S[4 + e] + (v2 - S[4 + e]) * k1[e]; ob = ob + S[4 + e] * q1[e]; }
                    const f32x2 o2 = oa + ob;
                    const float ox = red16(o2.x), oy = red16(o2.y);
                    osel = (kq == t16) ? (f32x2){ox, oy} : osel;
                    q0 = nq0; q1 = nq1; k0 = nk0; k1 = nk1; v2 = nv2;
                }
                *(f32x2*)(OR + (size_t)(row0 + c * 32 + tb * 16 + kq) * DM + h * 128 + col) = osel;
            }
            if (c + 1 < nch) HG_PROC(bufs + ((c + 1) & 1) * 10240);
            __syncthreads();
        }
#undef HG_LOAD
#undef HG_PROC
        float* so = p.out + (smp ? O_HGRN_S : O_HGRN_P) + ((size_t)(b * 8 + h) * 128 + 8 * kq) * 128 + col;
#pragma unroll
        for (int j = 0; j < 8; ++j) *(f32x2*)(so + (size_t)j * 128) = S[j];
    }
}
#ifndef HC_WRITE_O
#define HC_WRITE_O 1
#endif
#ifndef HC_WRITE_S
#define HC_WRITE_S 1
#endif
#ifndef HC_SERIAL_FIRST
#define HC_SERIAL_FIRST 0
#endif
DEV void hgrn_chunk(CP p, LAS unsigned char* lds) {
    const int tid = tid_(), wave = __builtin_amdgcn_readfirstlane(tid >> 6), lane = tid & 63, li = lane & 15, lq = lane >> 4;
    const bf16_t* P = (const bf16_t*)(p.ws + OFF_B);
    bf16_t* YB = (bf16_t*)(p.ws + OFF_H);
    const float* lbt = (const float*)(p.ws + OFF_TAB) + T_LB;
    constexpr int SSQ = 32768 + 77824;
    constexpr int YT = 32768 + 78848;
    constexpr int HB = 32768, QT = HB + 0, KT = HB + 8704, KH = HB + 17408, VT = HB + 27648, AT = HB + 37888, ST = HB + 40448, TOT = HB + 75264, BL = HB + 77312;
    const int k = tid & 127, j = tid >> 7;
    for (int item = bid_(); item < 256; item += gdim_()) {
        const int smp = item >> 7, it = item & 127, b = it >> 3, h = it & 7;
        const int L = smp ? 32 : 4096, row0 = smp ? MP + b * 32 : b * 4096, nch = L / 32;
        const float lb = lbt[h * 128 + k], oml = 1.f - lb;
        const float gnv = p.in[45][16 * wave + li]; const int gsh = (li & 1) * 16;
        f32x4 acc[8];
#pragma unroll
        for (int vi = 0; vi < 8; ++vi)
#pragma unroll
            for (int r = 0; r < 4; ++r) acc[vi][r] = smp ? p.in[6][((size_t)(b * 8 + h) * 128 + 16 * wave + 4 * lq + r) * 128 + 16 * vi + li] : 0.f;
        __syncthreads();
#pragma unroll
        for (int vi = 0; vi < 8; ++vi) { u32x2 w; w.x = cvt_pk_bf16(acc[vi][0], acc[vi][1]); w.y = cvt_pk_bf16(acc[vi][2], acc[vi][3]);
            *(LAS u32x2*)(lds + ST + (16 * vi + li) * 272 + (16 * wave + 4 * lq) * 2) = w; }
        unsigned rq[8], rf[8], rv[8];
        const int ksh = (k & 1) * 16;
#define HC_LOAD(c) do { _Pragma("unroll") for (int i = 0; i < 8; ++i) { const unsigned* pc = (const unsigned*)(P + (size_t)(row0 + (c) * 32 + 8 * j + i) * LDP_O + h * 128 + (k & ~1)); rq[i] = __builtin_nontemporal_load(pc); rf[i] = __builtin_nontemporal_load(pc + 512); rv[i] = __builtin_nontemporal_load(pc + 1024); } } while (0)
#define HC_PICK(w) __uint_as_float(((w) >> ksh) << 16)
        HC_LOAD(0);
        for (int c = 0; c < nch; ++c) {
            float cs[8], kkv[8], qs[8]; float run = 1.f;
#pragma unroll
            for (int i = 0; i < 8; ++i) { const float f = HC_PICK(rf[i]); const float sg = __builtin_amdgcn_rcpf(1.f + __builtin_amdgcn_exp2f(-1.44269504f * f)); const float ft = lb + oml * sg; kkv[i] = oml * (1.f - sg);
                run *= ft; cs[i] = run; const float qv = HC_PICK(rq[i]); qs[i] = qv * __builtin_amdgcn_rcpf(1.f + __builtin_amdgcn_exp2f(-1.44269504f * qv)); }
            *(LAS float*)(lds + TOT + (j * 128 + k) * 4) = run;
            { u32x4 w; w.x = ((rv[0] >> ksh) & 0xffffu) | ((rv[1] >> ksh) << 16); w.y = ((rv[2] >> ksh) & 0xffffu) | ((rv[3] >> ksh) << 16); w.z = ((rv[4] >> ksh) & 0xffffu) | ((rv[5] >> ksh) << 16); w.w = ((rv[6] >> ksh) & 0xffffu) | ((rv[7] >> ksh) << 16);
              *(LAS u32x4*)(lds + VT + k * 80 + 16 * j) = w; }
            __syncthreads();
            if (c > 0) { const int t = tid >> 4, ch16 = tid & 15; const u32x4 yv = *(const LAS u32x4*)(lds + YT + t * 272 + ch16 * 16);
                *(u32x4*)(YB + (size_t)(row0 + (c - 1) * 32 + t) * DM + h * 128 + ch16 * 8) = yv; }
            if (c + 1 < nch) HC_LOAD(c + 1);
            float pre = 1.f, bl = 1.f;
#pragma unroll
            for (int jj = 0; jj < 4; ++jj) { const float tv = *(const LAS float*)(lds + TOT + (jj * 128 + k) * 4); bl *= tv; pre *= (jj < j) ? tv : 1.f; }
            const float ebl = bl;
            if (j == 0) *(LAS float*)(lds + BL + k * 4) = ebl;
            float khp[8];
#pragma unroll
            for (int i = 0; i < 8; ++i) { const float e = pre * cs[i]; const float ie = __builtin_amdgcn_rcpf(e); const int t = 8 * j + i;
                *(LAS bf16_t*)(lds + QT + t * 272 + k * 2) = f2bf(qs[i] * e); *(LAS bf16_t*)(lds + KT + t * 272 + k * 2) = f2bf(kkv[i] * ie); khp[i] = kkv[i] * (ebl * ie); }
            { u32x4 w; w.x = cvt_pk_bf16(khp[0], khp[1]); w.y = cvt_pk_bf16(khp[2], khp[3]); w.z = cvt_pk_bf16(khp[4], khp[5]); w.w = cvt_pk_bf16(khp[6], khp[7]);
              *(LAS u32x4*)(lds + KH + k * 80 + 16 * j) = w; }
            __syncthreads();
            if (wave < 4) { const int ti = wave >> 1, si = wave & 1; f32x4 a1 = (f32x4){0.f, 0.f, 0.f, 0.f};
                if (!(ti == 0 && si == 1)) {
#pragma unroll
                    for (int k4 = 0; k4 < 4; ++k4) { const bf16x8 a = *(const LAS bf16x8*)(lds + QT + (16 * ti + li) * 272 + (32 * k4 + 8 * lq) * 2), bb = *(const LAS bf16x8*)(lds + KT + (16 * si + li) * 272 + (32 * k4 + 8 * lq) * 2);
                        a1 = __builtin_amdgcn_mfma_f32_16x16x32_bf16(a, bb, a1, 0, 0, 0); } }
#pragma unroll
                for (int r = 0; r < 4; ++r) { const int t = 16 * ti + 4 * lq + r, sx = 16 * si + li; *(LAS bf16_t*)(lds + AT + t * 80 + sx * 2) = f2bf(t >= sx ? a1[r] : 0.f); } }
            __syncthreads();
            f32x4 oo[2]; unsigned gw_[2][4];
            { const bf16x8 bV = *(const LAS bf16x8*)(lds + VT + (16 * wave + li) * 80 + 16 * lq); bf16x8 bS[4]; f32x4 sq;
#pragma unroll
              for (int k4 = 0; k4 < 4; ++k4) bS[k4] = *(const LAS bf16x8*)(lds + ST + (16 * wave + li) * 272 + (32 * k4 + 8 * lq) * 2);
#pragma unroll
              for (int ti = 0; ti < 2; ++ti) {
#pragma unroll
                  for (int r = 0; r < 4; ++r) gw_[ti][r] = *(const unsigned*)(P + (size_t)(row0 + c * 32 + 16 * ti + 4 * lq + r) * LDP_O + 3072 + h * 128 + 16 * wave + (li & ~1)); }
#pragma unroll
              for (int ti = 0; ti < 2; ++ti) { f32x4 o = (f32x4){0.f, 0.f, 0.f, 0.f};
                  const bf16x8 aA = *(const LAS bf16x8*)(lds + AT + (16 * ti + li) * 80 + 16 * lq); o = __builtin_amdgcn_mfma_f32_16x16x32_bf16(aA, bV, o, 0, 0, 0);
#pragma unroll
                  for (int k4 = 0; k4 < 4; ++k4) { const bf16x8 aQ = *(const LAS bf16x8*)(lds + QT + (16 * ti + li) * 272 + (32 * k4 + 8 * lq) * 2); o = __builtin_amdgcn_mfma_f32_16x16x32_bf16(aQ, bS[k4], o, 0, 0, 0); }
#pragma unroll
                  for (int r = 0; r < 4; ++r) sq[r] = red16(o[r] * o[r]);
                  if (li == 0) *(LAS f32x4*)(lds + SSQ + (wave * 32 + 16 * ti + 4 * lq) * 4) = sq;
                  oo[ti] = o; } }
            { const bf16x8 aK = *(const LAS bf16x8*)(lds + KH + (16 * wave + li) * 80 + 16 * lq); const f32x4 sc = *(const LAS f32x4*)(lds + BL + (16 * wave + 4 * lq) * 4);
#pragma unroll
              for (int vi = 0; vi < 8; ++vi) { const bf16x8 bV = *(const LAS bf16x8*)(lds + VT + (16 * vi + li) * 80 + 16 * lq); acc[vi] = __builtin_amdgcn_mfma_f32_16x16x32_bf16(aK, bV, acc[vi] * sc, 0, 0, 0); } }
            __syncthreads();
#pragma unroll
            for (int vi = 0; vi < 8; ++vi) { u32x2 w; w.x = cvt_pk_bf16(acc[vi][0], acc[vi][1]); w.y = cvt_pk_bf16(acc[vi][2], acc[vi][3]);
                *(LAS u32x2*)(lds + ST + (16 * vi + li) * 272 + (16 * wave + 4 * lq) * 2) = w; }
#pragma unroll
            for (int ti = 0; ti < 2; ++ti) { f32x4 tot = *(const LAS f32x4*)(lds + SSQ + (16 * ti + 4 * lq) * 4);
#pragma unroll
                for (int w8 = 1; w8 < 8; ++w8) tot = tot + *(const LAS f32x4*)(lds + SSQ + (w8 * 32 + 16 * ti + 4 * lq) * 4);
#pragma unroll
                for (int r = 0; r < 4; ++r) { const float rstd = __builtin_amdgcn_rsqf(tot[r] * (1.f / 128.f) + 1e-6f); const float gt = __uint_as_float((gw_[ti][r] >> gsh) << 16);
                    *(LAS bf16_t*)(lds + YT + (16 * ti + 4 * lq + r) * 272 + (16 * wave + li) * 2) = f2bf(oo[ti][r] * rstd * gnv * siluf_(gt)); } }
        }
        __syncthreads();
        { const int t = tid >> 4, ch16 = tid & 15; const u32x4 yv = *(const LAS u32x4*)(lds + YT + t * 272 + ch16 * 16);
          *(u32x4*)(YB + (size_t)(row0 + (nch - 1) * 32 + t) * DM + h * 128 + ch16 * 8) = yv; }
#undef HC_LOAD
#undef HC_PICK
        float* so = p.out + (smp ? O_HGRN_S : O_HGRN_P) + (size_t)(b * 8 + h) * 128 * 128;
#pragma unroll
        for (int vi = 0; vi < 8; ++vi)
#pragma unroll
            for (int r = 0; r < 4; ++r) if (HC_WRITE_S) so[(size_t)(16 * wave + 4 * lq + r) * 128 + 16 * vi + li] = acc[vi][r];
    }
}
DEV void hgrn_post(CP p) {
    const int tid = tid_(), wave = tid >> 6, lane = tid & 63, gw = bid_() * 8 + wave, NW = gdim_() * 8;
    const bf16_t* P = (const bf16_t*)(p.ws + OFF_B);
    const float* OR = (const float*)(p.ws + OFF_B + B_ORAW);
    bf16_t* YB = (bf16_t*)(p.ws + OFF_H);
    const int hq = lane >> 4, j8 = (lane & 15) * 8;
    const f32x4 g0 = *(const f32x4*)(p.in[45] + j8), g1 = *(const f32x4*)(p.in[45] + j8 + 4);
    for (int r = gw; r < MT; r += NW) {
        f32x4 oa[2], ob[2]; u32x4 gg[2];
#pragma unroll
        for (int ps = 0; ps < 2; ++ps) { const int c = (hq + 4 * ps) * 128 + j8;
            oa[ps] = *(const f32x4*)(OR + (size_t)r * DM + c); ob[ps] = *(const f32x4*)(OR + (size_t)r * DM + c + 4); gg[ps] = *(const u32x4*)(P + (size_t)r * LDP_O + 3072 + c); }
#pragma unroll
        for (int ps = 0; ps < 2; ++ps) { const int c = (hq + 4 * ps) * 128 + j8; const f32x4 a = oa[ps], b = ob[ps];
            const float ss = red16(((a[0] * a[0] + a[1] * a[1]) + (a[2] * a[2] + a[3] * a[3])) + ((b[0] * b[0] + b[1] * b[1]) + (b[2] * b[2] + b[3] * b[3])));
            const float rstd = rsqrtf(ss * (1.f / 128.f) + 1e-6f);
            const f32x4 x = a * rstd * g0, y = b * rstd * g1;
            u32x4 w; w.x = cvt_pk_bf16(x[0] * siluf_(bflo(gg[ps].x)), x[1] * siluf_(bfhi(gg[ps].x))); w.y = cvt_pk_bf16(x[2] * siluf_(bflo(gg[ps].y)), x[3] * siluf_(bfhi(gg[ps].y)));
            w.z = cvt_pk_bf16(y[0] * siluf_(bflo(gg[ps].z)), y[1] * siluf_(bfhi(gg[ps].z))); w.w = cvt_pk_bf16(y[2] * siluf_(bflo(gg[ps].w)), y[3] * siluf_(bfhi(gg[ps].w)));
            *(u32x4*)(YB + (size_t)r * DM + c) = w; }
    }
}

__global__ __launch_bounds__(512, 2) void mega_fwd(Params p_unused) {
    extern __shared__ __attribute__((aligned(16))) unsigned char shm[];
    LAS unsigned char* lds = (LAS unsigned char*)shm;
    cg::grid_group grid = cg::this_grid();
    pg8::StaticOrder S;
    volatile LAS unsigned* xst = (volatile LAS unsigned*)(lds + 131072);
    if (threadIdx.x < 2) xst[threadIdx.x] = 0u;
    __syncthreads();
    const XcdBarrier XB = xcd_barrier_post((unsigned*)(PP.ws + OFF_BAR), xst);
#define GDIM (gdim_())
#define WSP(off) (p.ws + (off))

    if (PH_MASK & 1) phase_prologue(PP, lds);
    grid.sync();
    { CP p = PP; pg8::Gemm g{(const bf16_t*)WSP(OFF_ACS), (const bf16_t*)WSP(OFF_B + B_ADA), 256, NMODS, 1024, 1024}; S.init(256, NMODS, GDIM, bid_());
      EpiAda E{(float*)WSP(OFF_MODS), p.in[10]}; if (PH_MASK & 2) pg8::gemm_phase(lds, g, S, E); }
    xcd_barrier(XB);

    for (int st = 0; st < 6; ++st) {
        const int l = st / 3, kind = st % 3;
        if (kind != 1) {
            const int f = kind >> 1, q = l * 2 + f;
            if (PH_MASK & 4) phase_norm(PP, l, kind, st == 0, kind == 2 ? l * 9216 + 5 * 1024 : ((st == 3) ? 8 * 1024 : -1), 0, kind == 2 ? 4 : 11, kind == 2 ? 1.0f : 0.5f);
            xcd_barrier(XB);
            { CP p = PP; pg8::Gemm g{(const bf16_t*)WSP(OFF_H), (const bf16_t*)WSP(OFF_W + W_UP + q * SZ_UP), MT, 5632, 1024, 1024}; S.init(MT, 5632, GDIM, bid_());
              EpiSwiglu E{(bf16_t*)WSP(OFF_B)}; if (PH_MASK & 8) pg8::gemm_phase(lds, g, S, E); }
            xcd_barrier(XB);
            { CP p = PP; pg8::Gemm g{(const bf16_t*)WSP(OFF_B), (const bf16_t*)WSP(OFF_W + W_DN + q * SZ_DN), MP, 1024, FF, FF}; S.init(MP, 1024, GDIM, bid_());
              EpiResid E{p.in[0], p.in[1], p.out, (const float*)WSP(OFF_MODS) + l * 9216 + (3 * kind + 2) * 1024, 0.5f, st == 0}; if (PH_MASK & 16) pg8::gemm_phase(lds, g, S, E); }
            { CP p = PP; pg8::Gemm g{(const bf16_t*)WSP(OFF_B), (const bf16_t*)WSP(OFF_W + W_DN + q * SZ_DN), MT, 1024, 256, FF}; pg8::SplitOrder S2; S2.init(1024, 11, GDIM, bid_());
              EpiPartial E{(float*)WSP(OFF_B + B_PART)}; if (PH_MASK & 16) pg8::gemm_phase(lds, g, S2, E); }
            xcd_barrier(XB);
        } else {
            if (PH_MASK & 4) phase_norm(PP, l, 1, 0, l * 9216 + 2 * 1024, l == 0, 11, 0.5f);
            xcd_barrier(XB);
            { CP p = PP; const int N = l ? 4096 : 2304;
              pg8::Gemm g{(const bf16_t*)WSP(OFF_H), (const bf16_t*)WSP(OFF_W + (l ? W_CIN : W_ABIN)), MT, N, 1024, 1024}; S.init(MT, N, GDIM, bid_());
              EpiBf16 E{(bf16_t*)WSP(OFF_B), N}; if (PH_MASK & 32) pg8::gemm_phase(lds, g, S, E); }
            xcd_barrier(XB);
            if (l == 0) {
                if (PH_MASK & 64) phase_even_prep(PP);
                if (DBL_MASK & 64) phase_even_prep(PP);
                if (PH_MASK & 128) s5_pass<false>(PP, lds);
                xcd_barrier(XB);
                { CP p = PP; pg8::Gemm g{(const bf16_t*)WSP(OFF_B + B_LORA), (const bf16_t*)WSP(OFF_W + W_LORA), MT, 1536, 256, 256}; S.init(MT, 1536, GDIM, bid_());
                  EpiLora E{(float*)WSP(OFF_B + B_DECAY), (bf16_t*)WSP(OFF_B + B_ABUF), (bf16_t*)WSP(OFF_B + B_GBUF), p.in[32], p.in[34]}; if (PH_MASK & 256) pg8::gemm_phase(lds, g, S, E); }
                if (PH_MASK & 512) s5_pass2(PP);
                xcd_barrier(XB);
                if (PH_MASK & 1024) rwkv_scan(PP, lds);
                if (DBL_MASK & 1024) { __syncthreads(); rwkv_scan(PP, lds); }
                __syncthreads();
                if (PH_MASK & 2048) s5_pass<true>(PP, lds);
                if (DBL_MASK & 2048) { __syncthreads(); s5_pass<true>(PP, lds); }
                xcd_barrier(XB);
                { CP p = PP; pg8::Gemm g{(const bf16_t*)WSP(OFF_B + B_YA), (const bf16_t*)WSP(OFF_W + W_GLU), MT, 512, 512, 512}; S.init(MT, 512, GDIM, bid_());
                  EpiGlu E{(const bf16_t*)WSP(OFF_B + B_YA), (bf16_t*)WSP(OFF_H)}; if (PH_MASK & 4096) pg8::gemm_phase(lds, g, S, E); }
                if (PH_MASK & 8192) rwkv_post(PP);
                if (DBL_MASK & 8192) rwkv_post(PP);
                xcd_barrier(XB);
            } else {
                if (PH_MASK & 16384) hgrn_chunk(PP, lds);
                if (DBL_MASK & 16384) { __syncthreads(); hgrn_chunk(PP, lds); }
                xcd_barrier(XB);
            }
            { CP p = PP; pg8::Gemm g{(const bf16_t*)WSP(OFF_H), (const bf16_t*)WSP(OFF_W + (l ? W_COUT : W_ABOUT)), MP, 1024, 1024, 1024}; S.init(MP, 1024, GDIM, bid_());
              EpiResid E{p.in[0], p.in[1], p.out, (const float*)WSP(OFF_MODS) + l * 9216 + 5 * 1024, 1.0f, 0}; if (PH_MASK & 65536) pg8::gemm_phase(lds, g, S, E); }
            { CP p = PP; pg8::Gemm g{(const bf16_t*)WSP(OFF_H), (const bf16_t*)WSP(OFF_W + (l ? W_COUT : W_ABOUT)), MT, 1024, 256, 1024}; pg8::SplitOrder S2; S2.init(1024, 4, GDIM, bid_());
              EpiPartial E{(float*)WSP(OFF_B + B_PART)}; if (PH_MASK & 65536) pg8::gemm_phase(lds, g, S2, E); }
            xcd_barrier(XB);
        }
    }
    if (PH_MASK & 131072) phase_final_norm(PP, 9216 + 8 * 1024);
}

constexpr int LDS_BYTES = 131072 + 16;
extern "C" void kernel_launch(void* const* d_in, const int* in_sizes, int n_in, void* d_out, int out_size, void* d_ws, size_t ws_size, hipStream_t stream) {
    static int grid = 0;
    if (grid == 0) {
        if (n_in != 47 || (size_t)out_size != O_END || ws_size < WS_NEED) { fprintf(stderr, "kernel_launch: unexpected shapes: n_in %d out %d ws %zu (need %zu)\n", n_in, out_size, ws_size, (size_t)WS_NEED); grid = -1; return; }
        int dev = 0, cus = 0, per_cu = 0;
        hipGetDevice(&dev); hipDeviceGetAttribute(&cus, hipDeviceAttributeMultiprocessorCount, dev);
        if (hipFuncSetAttribute((const void*)mega_fwd, hipFuncAttributeMaxDynamicSharedMemorySize, LDS_BYTES) != hipSuccess) { fprintf(stderr, "kernel_launch: hipFuncSetAttribute failed\n"); grid = -1; return; }
        if (hipOccupancyMaxActiveBlocksPerMultiprocessor(&per_cu, (const void*)mega_fwd, 512, LDS_BYTES) != hipSuccess || per_cu < 1) { fprintf(stderr, "kernel_launch: occupancy query says %d\n", per_cu); per_cu = 1; }
        (void)hipGetLastError();
        grid = cus;
    }
    if (grid < 0) return;
    Params p{};
    for (int i = 0; i < 47; ++i) p.in[i] = (const float*)d_in[i];
    p.out = (float*)d_out; p.ws = (unsigned char*)d_ws;
    (void)hipMemsetAsync((char*)d_ws + OFF_BAR, 0, XCD_BAR_WORDS * sizeof(unsigned), stream);
    void* args[] = {&p};
    hipError_t e = hipLaunchCooperativeKernel((const void*)mega_fwd, dim3(grid), dim3(512), args, LDS_BYTES, stream);
    if (e != hipSuccess) fprintf(stderr, "cooperative launch failed: %s (grid %d)\n", hipGetErrorString(e), grid);
}
```
